# Optimizing an MI355X kernel written in HIP

```python
import jax, jax.numpy as jnp
from jax import lax
import numpy as np

D_MODEL = 1024
BATCH = 8
SEQ = 2048
DEPTH = 1

GRID_W = 64
CTX_LEN = 256
ATTN_WIDTH = 512
N_HEADS = 8
N_KV_HEADS = 2
HEAD_DIM = ATTN_WIDTH // N_HEADS
KV_REP = N_HEADS // N_KV_HEADS
KV_WIDTH = N_KV_HEADS * HEAD_DIM
CONV_WIDTH = D_MODEL - ATTN_WIDTH
CONV_HEADS = 8
CONV_K = 3
MIX_WIDTH = ATTN_WIDTH + CONV_WIDTH
IN_COLS = ATTN_WIDTH + 2 * KV_WIDTH + 3 * CONV_WIDTH
ROPE_THETA = 10000.0
ROPE_AXIS_DIM = HEAD_DIM // 2
ROPE_FREQS = ROPE_AXIS_DIM // 2
Q_BLOCK = 128
N_GROUPS = 4
EXPERTS_PER_GROUP = 8
N_EXPERTS = N_GROUPS * EXPERTS_PER_GROUP
TOP_K = 2
D_EXPERT = 768
MOE_BLOCK = 128
N_MOD = 6
EPS = 1e-6

kernel_name = "hybrid_gqa_shortconv_hmoe_dit_block"


def rms_norm(x, g):
    xf = x.astype(jnp.float32)
    y = xf * lax.rsqrt(jnp.mean(xf * xf, axis=-1, keepdims=True) + EPS)
    return (y * g.astype(jnp.float32)).astype(x.dtype)


def head_rms(x, g, n_heads):
    xs = x.reshape(*x.shape[:-1], n_heads, -1)
    return rms_norm(xs, g.reshape(n_heads, -1)).reshape(x.shape)


def modulation(cond, w_mod, b_mod):
    mod = jax.nn.silu(cond) @ w_mod + b_mod
    return jnp.split(mod[..., None, :], N_MOD, axis=-1)


def axial_rope_tables(n_tokens, dtype):
    rows = n_tokens // GRID_W
    row_idx = jnp.repeat(jnp.arange(rows, dtype=jnp.float32), GRID_W)
    col_idx = jnp.tile(jnp.arange(GRID_W, dtype=jnp.float32), rows)
    inv_freq = ROPE_THETA ** (-jnp.arange(0, ROPE_AXIS_DIM, 2, dtype=jnp.float32) / ROPE_AXIS_DIM)
    ang = jnp.stack([row_idx[:, None] * inv_freq, col_idx[:, None] * inv_freq], axis=1)
    return jnp.cos(ang).astype(dtype), jnp.sin(ang).astype(dtype)


def apply_axial_rope(x, cos, sin):
    xs = x.reshape(*x.shape[:-1], 2, 2, ROPE_FREQS)
    x1, x2 = xs[..., 0, :], xs[..., 1, :]
    c, s = cos[:, None], sin[:, None]
    return jnp.stack([x1 * c - x2 * s, x1 * s + x2 * c], axis=-2).reshape(x.shape)


def in_proj(h, w_in, q_g, k_g):
    z = h @ w_in
    b, s = h.shape[:2]
    cuts = [ATTN_WIDTH, ATTN_WIDTH + KV_WIDTH, ATTN_WIDTH + 2 * KV_WIDTH,
            ATTN_WIDTH + 2 * KV_WIDTH + CONV_WIDTH, ATTN_WIDTH + 2 * KV_WIDTH + 2 * CONV_WIDTH]
    q, k, v, gb, gc, u = jnp.split(z, cuts, axis=-1)
    q = rms_norm(q.reshape(b, s, N_HEADS, HEAD_DIM), q_g)
    k = rms_norm(k.reshape(b, s, N_KV_HEADS, HEAD_DIM), k_g)
    v = v.reshape(b, s, N_KV_HEADS, HEAD_DIM)
    return q, k, v, gb, gc, u


def attend(q, k, v):
    s = jnp.einsum('bqgrd,bkgd->bgrqk', q, k, preferred_element_type=jnp.float32) * (HEAD_DIM ** -0.5)
    p = jax.nn.softmax(s, axis=-1).astype(v.dtype)
    return jnp.einsum('bgrqk,bkgd->bqgrd', p, v)


def latent_attention(q, k_all, v_all):
    b, s = q.shape[:2]
    nb = s // Q_BLOCK
    qb = q.reshape(b, nb, Q_BLOCK, N_KV_HEADS, KV_REP, HEAD_DIM).transpose(1, 0, 2, 3, 4, 5)
    ob = lax.map(lambda qi: attend(qi, k_all, v_all), qb)
    return ob.transpose(1, 0, 2, 3, 4, 5).reshape(b, s, ATTN_WIDTH)


def short_conv(gb, gc, u, conv_w):
    v = gc * u
    vp = jnp.pad(v, ((0, 0), (1, 1), (0, 0)))
    y = conv_w[0] * vp[:, :-2] + conv_w[1] * vp[:, 1:-1] + conv_w[2] * vp[:, 2:]
    return gb * y


def merge_out(a, cv, attn_g, conv_g, w_out):
    return jnp.concatenate([head_rms(a, attn_g, N_HEADS), head_rms(cv, conv_g, CONV_HEADS)], axis=-1) @ w_out


def hier_moe(h, w_group, w_router, w_gate, w_up, w_down):
    d = h.shape[-1]
    ht = h.reshape(-1, d)
    n = ht.shape[0]
    g_prob = jax.nn.softmax((ht @ w_group).astype(jnp.float32), axis=-1)
    g_sel = jnp.argmax(g_prob, axis=-1)
    g_w = jnp.take_along_axis(g_prob, g_sel[:, None], axis=1)[:, 0]
    e_logits = (ht @ w_router).astype(jnp.float32).reshape(n, N_GROUPS, EXPERTS_PER_GROUP)
    e_logits = jnp.take_along_axis(e_logits, g_sel[:, None, None], axis=1)[:, 0]
    e_prob = jax.nn.softmax(e_logits, axis=-1)
    top_p, top_i = lax.top_k(e_prob, TOP_K)
    top_p = top_p / jnp.sum(top_p, axis=-1, keepdims=True)
    wts = (g_w[:, None] * top_p).reshape(-1)
    eid = (g_sel[:, None] * EXPERTS_PER_GROUP + top_i).reshape(-1).astype(jnp.int32)
    tok = jnp.repeat(jnp.arange(n, dtype=jnp.int32), TOP_K)
    m = eid.shape[0]
    order = jnp.argsort(eid)
    s_e, s_tok, s_w = eid[order], tok[order], wts[order]
    counts = jnp.bincount(eid, length=N_EXPERTS).astype(jnp.int32)
    starts = jnp.cumsum(counts) - counts
    padded = ((counts + MOE_BLOCK - 1) // MOE_BLOCK) * MOE_BLOCK
    pstarts = jnp.cumsum(padded) - padded
    pends = pstarts + padded
    dest = pstarts[s_e] + (jnp.arange(m, dtype=jnp.int32) - starts[s_e])
    p_rows = m + N_EXPERTS * MOE_BLOCK
    n_blk = p_rows // MOE_BLOCK
    xbuf = jnp.zeros((p_rows, d), h.dtype).at[dest].set(ht[s_tok])
    blk_start = jnp.arange(n_blk, dtype=jnp.int32) * MOE_BLOCK
    blk_e = jnp.minimum(jnp.searchsorted(pends, blk_start, side='right'), N_EXPERTS - 1)

    def expert_block(args):
        xb, e = args
        return (jax.nn.silu(xb @ w_gate[e]) * (xb @ w_up[e])) @ w_down[e]

    ybuf = lax.map(expert_block, (xbuf.reshape(n_blk, MOE_BLOCK, d), blk_e)).reshape(p_rows, d)
    y = ybuf[dest] * s_w[:, None].astype(h.dtype)
    return jax.ops.segment_sum(y, s_tok, num_segments=n).reshape(h.shape)


def trunk_layer(x, ctx, c, c_ctx, cos, sin, w_mod, b_mod, norm1_g, w_in, q_norm_g, k_norm_g,
                conv_w, attn_out_g, conv_out_g, w_out, norm2_g, w_group, w_router, w_gate, w_up,
                w_down, update_ctx):
    sh1, sc1, gt1, sh2, sc2, gt2 = modulation(c, w_mod, b_mod)
    csh1, csc1, cgt1, csh2, csc2, cgt2 = modulation(c_ctx, w_mod, b_mod)
    hx = rms_norm(x, norm1_g) * (1.0 + sc1) + sh1
    hc = rms_norm(ctx, norm1_g) * (1.0 + csc1) + csh1
    qx, kx, vx, bx, cx, ux = in_proj(hx, w_in, q_norm_g, k_norm_g)
    qc, kc, vc, bc, cc, uc = in_proj(hc, w_in, q_norm_g, k_norm_g)
    qx = apply_axial_rope(qx, cos, sin)
    kx = apply_axial_rope(kx, cos, sin)
    k_all = jnp.concatenate([kc, kx], axis=1)
    v_all = jnp.concatenate([vc, vx], axis=1)
    ax = latent_attention(qx, k_all, v_all)
    convx = short_conv(bx, cx, ux, conv_w)
    x_new = x + gt1 * merge_out(ax, convx, attn_out_g, conv_out_g, w_out)
    hx2 = rms_norm(x_new, norm2_g) * (1.0 + sc2) + sh2
    x_new = x_new + gt2 * hier_moe(hx2, w_group, w_router, w_gate, w_up, w_down)
    if update_ctx:
        b = ctx.shape[0]
        ac = attend(qc.reshape(b, -1, N_KV_HEADS, KV_REP, HEAD_DIM), kc, vc).reshape(b, -1, ATTN_WIDTH)
        convc = short_conv(bc, cc, uc, conv_w)
        ctx = ctx + cgt1 * merge_out(ac, convc, attn_out_g, conv_out_g, w_out)
        hc2 = rms_norm(ctx, norm2_g) * (1.0 + csc2) + csh2
        ctx = ctx + cgt2 * hier_moe(hc2, w_group, w_router, w_gate, w_up, w_down)
    return x_new, ctx


def setup_inputs(seed: int = 0) -> dict:
    key = jax.random.key(seed)
    ks = jax.random.split(key, 21)
    f32 = jnp.float32
    L, D = DEPTH, D_MODEL

    def nrm(k, shape, scale):
        return jax.random.normal(k, shape, f32) * scale

    return {
        "x": nrm(ks[0], (BATCH, SEQ, D), 1.0),
        "c": nrm(ks[1], (BATCH, D), 1.0),
        "ctx": nrm(ks[2], (BATCH, CTX_LEN, D), 1.0),
        "c_ctx": nrm(ks[3], (D,), 1.0),
        "w_mod": nrm(ks[4], (L, D, N_MOD * D), 0.5 * D ** -0.5),
        "b_mod": nrm(ks[5], (L, N_MOD * D), 0.02),
        "norm1_g": 1.0 + nrm(ks[6], (L, D), 0.02),
        "w_in": nrm(ks[7], (L, D, IN_COLS), D ** -0.5),
        "q_norm_g": 1.0 + nrm(ks[8], (L, HEAD_DIM), 0.02),
        "k_norm_g": 1.0 + nrm(ks[9], (L, HEAD_DIM), 0.02),
        "conv_w": nrm(ks[10], (L, CONV_K, CONV_WIDTH), CONV_K ** -0.5),
        "attn_out_g": 1.0 + nrm(ks[11], (L, ATTN_WIDTH), 0.02),
        "conv_out_g": 1.0 + nrm(ks[12], (L, CONV_WIDTH), 0.02),
        "w_out": nrm(ks[13], (L, MIX_WIDTH, D), MIX_WIDTH ** -0.5),
        "norm2_g": 1.0 + nrm(ks[14], (L, D), 0.02),
        "w_group": nrm(ks[15], (L, D, N_GROUPS), D ** -0.5),
        "w_router": nrm(ks[16], (L, D, N_EXPERTS), D ** -0.5),
        "w_gate": nrm(ks[17], (L, N_EXPERTS, D, D_EXPERT), D ** -0.5),
        "w_up": nrm(ks[18], (L, N_EXPERTS, D, D_EXPERT), D ** -0.5),
        "w_down": nrm(ks[19], (L, N_EXPERTS, D_EXPERT, D), D_EXPERT ** -0.5),
        "final_g": 1.0 + nrm(ks[20], (D,), 0.02),
    }


def reference(x, c, ctx, c_ctx, w_mod, b_mod, norm1_g, w_in, q_norm_g, k_norm_g, conv_w,
              attn_out_g, conv_out_g, w_out, norm2_g, w_group, w_router, w_gate, w_up, w_down,
              final_g):
    cos, sin = axial_rope_tables(x.shape[1], x.dtype)
    for i in range(DEPTH):
        x, ctx = trunk_layer(x, ctx, c, c_ctx, cos, sin, w_mod[i], b_mod[i], norm1_g[i], w_in[i],
                             q_norm_g[i], k_norm_g[i], conv_w[i], attn_out_g[i], conv_out_g[i],
                             w_out[i], norm2_g[i], w_group[i], w_router[i], w_gate[i], w_up[i],
                             w_down[i], update_ctx=(i < DEPTH - 1))
    return rms_norm(x, final_g)
```

```cpp
#include <hip/hip_runtime.h>
#include <hip/hip_bf16.h>
#include <cstdio>
#include <cstdint>

#ifndef MK_N_LAUNCHES
#define MK_N_LAUNCHES 1
#endif
constexpr int N_PHASES = 9;

constexpr int DM = 1024, NB = 8, SEQ = 2048, NTOK = NB * SEQ, CTXL = 256, NCTX = NB * CTXL, MROWS = NTOK + NCTX;
constexpr int NCOLS = 2304, AW = 512, HD = 64, KVW = 128, CW = 512, SKV = CTXL + SEQ;
constexpr int NE = 32, EPG = 8, DE = 768, NUP = 2 * DE, LISTCAP = NTOK;
constexpr int PROWS = 2 * NTOK + NE * 256;
constexpr float EPS = 1e-6f;
constexpr float C2 = 0.125f * 1.4426950408889634f;

constexpr size_t MiB = 1u << 20;
constexpr size_t WS_CTL = 0, CTL_ZERO_BYTES = 1 * MiB;
constexpr size_t WS_MOD = 1 * MiB;
constexpr size_t WS_ROPE = WS_MOD + 256 * 1024;
constexpr size_t WS_TOKI = 2 * MiB;
constexpr size_t WS_TOKW = WS_TOKI + 256 * 1024;
constexpr size_t WS_LIST = 3 * MiB;
constexpr size_t WS_WIN = 5 * MiB;
constexpr size_t WS_WOUT = 10 * MiB;
constexpr size_t WS_WUP = 12 * MiB;
constexpr size_t WS_WDN = 108 * MiB;
constexpr size_t WS_HX2 = 156 * MiB;
constexpr size_t WS_R1 = 188 * MiB;
constexpr size_t WS_HX = WS_R1;
constexpr size_t WS_Q = WS_R1 + 36 * MiB;
constexpr size_t WS_KB = WS_R1 + 52 * MiB;
constexpr size_t WS_VB = WS_R1 + 57 * MiB;
constexpr size_t WS_GB = WS_R1 + 62 * MiB;
constexpr size_t WS_WB = WS_R1 + 78 * MiB;
constexpr size_t WS_MIX = WS_R1 + 94 * MiB;
constexpr size_t WS_HB = WS_R1;
constexpr size_t WS_YB = WS_R1 + 60 * MiB;
constexpr size_t WS_END = WS_R1 + 140 * MiB;
constexpr int CW_TMO = 0;
constexpr int CW_CNT = 64;
constexpr int CW_BAR = 4096;

constexpr int RING_BYTES = 131072;
constexpr int TAB_OFF = RING_BYTES;
constexpr int MISC_OFF = RING_BYTES + 4096;
constexpr int LDS_BYTES = 147456;

#define GAS __attribute__((address_space(1)))
#define LAS __attribute__((address_space(3)))
typedef unsigned short bf16_t;
typedef unsigned u32x4 __attribute__((ext_vector_type(4)));
typedef unsigned u32x2 __attribute__((ext_vector_type(2)));
typedef float f32x4 __attribute__((ext_vector_type(4)));
typedef float f32x2 __attribute__((ext_vector_type(2)));
typedef short bf16x8 __attribute__((ext_vector_type(8)));
typedef GAS unsigned gu32;
#define RLX_AGENT __ATOMIC_RELAXED, __HIP_MEMORY_SCOPE_AGENT

__device__ __forceinline__ unsigned cvt_pk_bf16(float lo, float hi) { unsigned r; asm volatile("v_cvt_pk_bf16_f32 %0, %1, %2" : "=v"(r) : "v"(lo), "v"(hi)); return r; }
__device__ __forceinline__ float bf_lo(unsigned w) { return __uint_as_float(w << 16); }
__device__ __forceinline__ float bf_hi(unsigned w) { return __uint_as_float(w & 0xffff0000u); }
__device__ __forceinline__ float wave_sum(float v) {
#pragma unroll
    for (int o = 1; o < 64; o <<= 1) v += __shfl_xor(v, o);
    return v;
}
__host__ __device__ __forceinline__ int invperm32(int l) { return 16 * ((l >> 2) & 1) + 4 * (l >> 3) + (l & 3); }

__host__ __device__ __forceinline__ int drow_win(int n) {
    if (n < 512) { const int h = n >> 6, d = n & 63; return 256 * (h >> 2) + 128 * (d >> 5) + 32 * (h & 3) + (d & 31); }
    if (n < 768) { const int hh = (n - 512) >> 6, d = n & 63; return 512 + 128 * (d >> 5) + 32 * hh + (d & 31); }
    if (n < 1280) { const int c = n - 768; return 768 + (c & ~31) + invperm32(c & 31); }
    if (n < 1792) { const int c = n - 1280; return 1280 + 256 * (c >> 7) + ((c & 127) & ~31) + invperm32(c & 31); }
    { const int c = n - 1792; return 1280 + 256 * (c >> 7) + 128 + ((c & 127) & ~31) + invperm32(c & 31); }
}
__host__ __device__ __forceinline__ int drow_gu(int n, int up) { return 256 * (n >> 7) + 128 * up + ((n & 127) & ~31) + invperm32(n & 31); }
__host__ __device__ __forceinline__ int drow_dn(int n) { return (n & ~31) + invperm32(n & 31); }

namespace pg8 {
constexpr int BM = 256, BK = 64, HALF = 128, HTB = HALF * BK * 2, STAGE_BYTES = 8 * HTB;
__host__ __device__ __forceinline__ int lds_byte(int r, int c) { const int st = (r >> 4) * 2 + (c >> 5), rr = r & 15, cc = c & 31, ob = rr * 64 + cc * 2; return st * 1024 + (ob ^ (((ob >> 9) & 1) << 5)); }
__host__ __device__ __forceinline__ void stage_rc(int b, int& R, int& C) { const int st = b / 1024, sb = b % 1024, swz = sb ^ (((sb >> 9) & 1) << 5); R = (st >> 1) * 16 + swz / 64; C = (st & 1) * 32 + (swz % 64) / 2; }

struct Unit { int pm, pn, ui, e; };

template <class Epi, class Sched, bool ALIGN_EPI>
__device__ __forceinline__ void gemm_phase(LAS unsigned char* lds, const char* Abase, const int K, const Sched& S, const Epi& E) {
    const int tid = threadIdx.x, wid = __builtin_amdgcn_readfirstlane(tid >> 6), lane = tid & 63, wr = wid >> 2, wc = wid & 3, fr = lane & 15, fq = lane >> 4;
    const int nt = K / BK;
    int Rr[2], Cb[2]; unsigned voffB[2];
#pragma unroll
    for (int i = 0; i < 2; ++i) { int R, C; stage_rc(tid * 16 + i * 8192, R, C); Rr[i] = R; Cb[i] = C * 2; voffB[i] = (unsigned)(R * K + C) * 2u; }
    const size_t kstep = (size_t)(BK * 2);
    const size_t hstep = (size_t)HALF * K * 2;
    const unsigned ldsw = (unsigned)wid * 1024u;
    const int aoff = lds_byte(wr * 64 + fr, fq * 8), boff = lds_byte(wc * 32 + fr, fq * 8);
#define PG8_SA(b, h) (((b) * 2 + (h)) * HTB)
#define PG8_SB(b, h) ((4 + (b) * 2 + (h)) * HTB)
#define PG8_STAGEB(bufoff, gbase) do { _Pragma("unroll") for (int _i = 0; _i < 2; ++_i) \
        __builtin_amdgcn_global_load_lds((const unsigned*)((const char*)(gbase) + voffB[_i]), (LAS unsigned*)(lds + (bufoff) + ldsw + _i * 8192), 16, 0, 0); } while (0)
#define PG8_STAGEA(bufoff, o0, o1, kb) do { \
        __builtin_amdgcn_global_load_lds((const unsigned*)(Abase + (size_t)(o0) + (size_t)(kb)), (LAS unsigned*)(lds + (bufoff) + ldsw), 16, 0, 0); \
        __builtin_amdgcn_global_load_lds((const unsigned*)(Abase + (size_t)(o1) + (size_t)(kb)), (LAS unsigned*)(lds + (bufoff) + ldsw + 8192), 16, 0, 0); } while (0)
#define PG8_LDA(dst, b, h) do { _Pragma("unroll") for (int m = 0; m < 4; ++m) _Pragma("unroll") for (int k = 0; k < 2; ++k) dst[m][k] = *(const LAS bf16x8*)(lds + PG8_SA(b, h) + aoff + m * 2048 + k * 1024); } while (0)
#define PG8_LDB(dst, b, h) do { _Pragma("unroll") for (int n = 0; n < 2; ++n) _Pragma("unroll") for (int k = 0; k < 2; ++k) dst[n][k] = *(const LAS bf16x8*)(lds + PG8_SB(b, h) + boff + n * 2048 + k * 1024); } while (0)
#define PG8_MMA(ai, bj, At, Bt) do { __builtin_amdgcn_s_setprio(1); _Pragma("unroll") for (int m = 0; m < 4; ++m) _Pragma("unroll") for (int n = 0; n < 2; ++n) _Pragma("unroll") for (int k = 0; k < 2; ++k) \
        acc[ai][bj][m][n] = __builtin_amdgcn_mfma_f32_16x16x32_bf16(Bt[n][k], At[m][k], acc[ai][bj][m][n], 0, 0, 0); __builtin_amdgcn_s_setprio(0); } while (0)
#define PG8_WAIT_V(n) asm volatile("s_waitcnt vmcnt(" #n ")" ::: "memory")
#define PG8_WAIT_L(n) asm volatile("s_waitcnt lgkmcnt(" #n ")" ::: "memory")
#define PG8_BAR __builtin_amdgcn_s_barrier()
#define PG8_SCHED __builtin_amdgcn_sched_barrier(0)
    Unit cur, nxt; int ui = 0;
    if (!S.next(0, cur)) return;
    f32x4 acc[2][2][4][2];
#pragma unroll
    for (int a = 0; a < 2; ++a)
#pragma unroll
        for (int b = 0; b < 2; ++b)
#pragma unroll
            for (int m = 0; m < 4; ++m)
#pragma unroll
                for (int n = 0; n < 2; ++n) acc[a][b][m][n] = (f32x4){0.f, 0.f, 0.f, 0.f};
    bf16x8 At[4][2], B0[2][2], B1[2][2];
    unsigned ao[2][2], an[2][2];
    S.a_off(cur, Rr, Cb, ao);
    const char* cB = S.b_ptr(cur);
    PG8_STAGEB(PG8_SB(0, 0), cB); PG8_STAGEB(PG8_SB(0, 1), cB + hstep); PG8_STAGEA(PG8_SA(0, 0), ao[0][0], ao[0][1], 0); PG8_STAGEA(PG8_SA(0, 1), ao[1][0], ao[1][1], 0);
    if (wr == 1) PG8_BAR;
    PG8_WAIT_V(2); PG8_BAR;
    PG8_STAGEB(PG8_SB(1, 0), cB + kstep); PG8_STAGEA(PG8_SA(1, 0), ao[0][0], ao[0][1], kstep); PG8_STAGEB(PG8_SB(1, 1), cB + hstep + kstep);
    PG8_WAIT_V(6); PG8_BAR;
    for (;;) {
        const bool has_next = S.next(ui + 1, nxt);
        const char* nB = cB;
        if (has_next) { S.a_off(nxt, Rr, Cb, an); nB = S.b_ptr(nxt); }
        else {
#pragma unroll
            for (int h = 0; h < 2; ++h)
#pragma unroll
                for (int i = 0; i < 2; ++i) an[h][i] = ao[h][i];
        }
        for (int t = 0; t < nt; t += 2) {
            const bool last = (t == nt - 2);
            const size_t k1 = (size_t)(t + 1) * kstep;
            const size_t k2 = last ? 0 : (size_t)(t + 2) * kstep, k3 = k2 + kstep;
            const unsigned s00 = last ? an[0][0] : ao[0][0], s01 = last ? an[0][1] : ao[0][1], s10 = last ? an[1][0] : ao[1][0], s11 = last ? an[1][1] : ao[1][1];
            const char* b2 = last ? nB : cB + (size_t)(t + 2) * kstep; const char* b3 = b2 + kstep;
            PG8_LDB(B0, 0, 0); PG8_LDB(B1, 0, 1); PG8_SCHED; PG8_LDA(At, 0, 0); PG8_STAGEA(PG8_SA(1, 1), ao[1][0], ao[1][1], k1);
            PG8_WAIT_V(8); PG8_WAIT_L(0); PG8_BAR; PG8_MMA(0, 0, At, B0); PG8_MMA(0, 1, At, B1); PG8_BAR; PG8_SCHED;
            PG8_LDA(At, 0, 1); PG8_STAGEB(PG8_SB(0, 0), b2); PG8_STAGEB(PG8_SB(0, 1), b2 + hstep); PG8_STAGEA(PG8_SA(0, 0), s00, s01, k2);
            PG8_WAIT_V(8); PG8_WAIT_L(0); PG8_BAR; PG8_MMA(1, 0, At, B0); PG8_MMA(1, 1, At, B1); PG8_BAR; PG8_SCHED;
            PG8_LDB(B0, 1, 0); PG8_LDB(B1, 1, 1); PG8_SCHED; PG8_LDA(At, 1, 0); PG8_STAGEA(PG8_SA(0, 1), s10, s11, k2);
            PG8_WAIT_V(8); PG8_WAIT_L(0); PG8_BAR; PG8_MMA(0, 0, At, B0); PG8_MMA(0, 1, At, B1); PG8_BAR; PG8_SCHED;
            PG8_LDA(At, 1, 1); PG8_STAGEB(PG8_SB(1, 0), b3); PG8_STAGEB(PG8_SB(1, 1), b3 + hstep); PG8_STAGEA(PG8_SA(1, 0), s00, s01, k3);
            PG8_WAIT_V(8); PG8_WAIT_L(0); PG8_BAR; PG8_MMA(1, 0, At, B0); PG8_MMA(1, 1, At, B1); PG8_BAR; PG8_SCHED;
        }
        if constexpr (ALIGN_EPI) { if (wr == 0) PG8_BAR; }
        E(acc, cur, wr, wc, fr, fq);
        if (!has_next) break;
#pragma unroll
        for (int a = 0; a < 2; ++a)
#pragma unroll
            for (int b = 0; b < 2; ++b)
#pragma unroll
                for (int m = 0; m < 4; ++m)
#pragma unroll
                    for (int n = 0; n < 2; ++n) acc[a][b][m][n] = (f32x4){0.f, 0.f, 0.f, 0.f};
        cur = nxt; cB = nB; ++ui;
#pragma unroll
        for (int h = 0; h < 2; ++h)
#pragma unroll
            for (int i = 0; i < 2; ++i) ao[h][i] = an[h][i];
        if constexpr (ALIGN_EPI) { if (wr == 1) PG8_BAR; }
    }
    PG8_WAIT_V(0);
    if constexpr (!ALIGN_EPI) { if (wr == 0) PG8_BAR; }
    PG8_BAR;
#undef PG8_SA
#undef PG8_SB
#undef PG8_STAGEA
#undef PG8_STAGEB
#undef PG8_LDA
#undef PG8_LDB
#undef PG8_MMA
#undef PG8_WAIT_V
#undef PG8_WAIT_L
#undef PG8_BAR
#undef PG8_SCHED
}

__device__ __forceinline__ void dense_off(int pm, int K, const int (&R)[2], const int (&Cb)[2], unsigned (&off)[2][2]) {
#pragma unroll
    for (int h = 0; h < 2; ++h)
#pragma unroll
        for (int i = 0; i < 2; ++i) off[h][i] = (unsigned)((pm * 256 + h * 128 + R[i]) * K) * 2u + (unsigned)Cb[i];
}
struct GridOrder {
    int nM, nN, G, c, nExtra, extra_pn, K; const char* Bt;
    __device__ __forceinline__ bool next(int i, Unit& u) const {
        const int L = i * G + c, nwg = nM * nN; u.ui = i; u.e = 0;
        if (L >= nwg) { if (L - nwg < nExtra) { u.pm = nM + (L - nwg); u.pn = extra_pn; return true; } return false; }
        int wgid = L; { const int q = nwg / 8, r = nwg % 8, xcd = wgid % 8, off = wgid / 8; wgid = (xcd < r ? xcd * (q + 1) : r * (q + 1) + (xcd - r) * q) + off; }
        const int nig = 8 * nN, gid = wgid / nig, fm = gid * 8, gsz = (nM - fm) < 8 ? (nM - fm) : 8;
        u.pm = fm + ((wgid % nig) % gsz); u.pn = (wgid % nig) / gsz; return true;
    }
    __device__ __forceinline__ void a_off(const Unit& u, const int (&R)[2], const int (&Cb)[2], unsigned (&off)[2][2]) const { dense_off(u.pm, K, R, Cb, off); }
    __device__ __forceinline__ const char* b_ptr(const Unit& u) const { return Bt + (size_t)u.pn * 256 * K * 2; }
};
template <bool GATHER, int NN>
struct MoeOrder {
    int G, vcu, U, incl; int K; const char* Bt; size_t estride; const LAS int* tab;
    __device__ __forceinline__ bool next(int i, Unit& u) const {
        const int L = i * G + vcu; if (L >= U) return false;
        u.ui = i; u.pm = L / NN; u.pn = L - u.pm * NN;
        u.e = (int)__popcll(__ballot((threadIdx.x & 63) < 32 && incl <= u.pm)) & 31; return true;
    }
    __device__ __forceinline__ void a_off(const Unit& u, const int (&R)[2], const int (&Cb)[2], unsigned (&off)[2][2]) const {
        if constexpr (GATHER) {
#pragma unroll
            for (int h = 0; h < 2; ++h)
#pragma unroll
                for (int i = 0; i < 2; ++i) { const int tok = tab[u.ui * 256 + h * 128 + R[i]]; off[h][i] = (unsigned)(tok * K) * 2u + (unsigned)Cb[i]; }
        } else dense_off(u.pm, K, R, Cb, off);
    }
    __device__ __forceinline__ const char* b_ptr(const Unit& u) const { return Bt + (size_t)u.e * estride + (size_t)u.pn * 256 * K * 2; }
};

struct EpiIn {
    bf16_t *Q, *KB, *VB, *GB, *WB; const float *qg, *kg, *cosT, *sinT;
    __device__ __forceinline__ void operator()(const f32x4 (&acc)[2][2][4][2], const Unit& u, int wr, int wc, int fr, int fq) const {
        const int pn = u.pn, pm = u.pm;
        if (pn >= 3) {
            if (pn < 5) {
#pragma unroll
                for (int ai = 0; ai < 2; ++ai)
#pragma unroll
                    for (int m = 0; m < 4; ++m) { bf16_t* rowp = GB + (size_t)(pm * 256 + ai * 128 + wr * 64 + m * 16 + fr) * CW + (pn - 3) * 256 + wc * 32 + 8 * fq;
#pragma unroll
                        for (int bj = 0; bj < 2; ++bj) { const f32x4 v0 = acc[ai][bj][m][0], v1 = acc[ai][bj][m][1]; u32x4 w; w.x = cvt_pk_bf16(v0[0], v0[1]); w.y = cvt_pk_bf16(v0[2], v0[3]); w.z = cvt_pk_bf16(v1[0], v1[1]); w.w = cvt_pk_bf16(v1[2], v1[3]);
                            *(u32x4*)(rowp + bj * 128) = w; } }
            } else {
#pragma unroll
                for (int ai = 0; ai < 2; ++ai)
#pragma unroll
                    for (int m = 0; m < 4; ++m) { bf16_t* rowp = WB + (size_t)(pm * 256 + ai * 128 + wr * 64 + m * 16 + fr) * CW + (pn - 5) * 128 + wc * 32 + 8 * fq;
                        const f32x4 v0 = acc[ai][0][m][0] * acc[ai][1][m][0], v1 = acc[ai][0][m][1] * acc[ai][1][m][1];
                        u32x4 w; w.x = cvt_pk_bf16(v0[0], v0[1]); w.y = cvt_pk_bf16(v0[2], v0[3]); w.z = cvt_pk_bf16(v1[0], v1[1]); w.w = cvt_pk_bf16(v1[2], v1[3]);
                        *(u32x4*)rowp = w; }
            }
            return;
        }
        const bool isq = pn < 2, isv = (pn == 2) && (wc >= 2), latent = pm < 64;
        f32x4 g[2][2];
#pragma unroll
        for (int bj = 0; bj < 2; ++bj)
#pragma unroll
            for (int n = 0; n < 2; ++n) g[bj][n] = isv ? (f32x4){1.f, 1.f, 1.f, 1.f} : *(const f32x4*)((isq ? qg : kg) + 32 * bj + 16 * n + 4 * fq);
#pragma unroll
        for (int ai = 0; ai < 2; ++ai)
#pragma unroll
            for (int m = 0; m < 4; ++m) {
                const int rl = ai * 128 + wr * 64 + m * 16 + fr;
                f32x4 x[2][2];
#pragma unroll
                for (int bj = 0; bj < 2; ++bj)
#pragma unroll
                    for (int n = 0; n < 2; ++n) x[bj][n] = acc[ai][bj][m][n];
                if (!isv) {
                    float ss = 0.f;
#pragma unroll
                    for (int bj = 0; bj < 2; ++bj)
#pragma unroll
                        for (int n = 0; n < 2; ++n) { const f32x4 v = x[bj][n]; ss += (v[0] * v[0] + v[1] * v[1]) + (v[2] * v[2] + v[3] * v[3]); }
                    ss += __shfl_xor(ss, 16); ss += __shfl_xor(ss, 32);
                    const float rstd = 1.0f / sqrtf(ss * (1.0f / 64.0f) + EPS);
#pragma unroll
                    for (int bj = 0; bj < 2; ++bj)
#pragma unroll
                        for (int n = 0; n < 2; ++n) x[bj][n] = x[bj][n] * rstd * g[bj][n];
                    if (latent) {
                        const int t = (pm * 256 + rl) & (SEQ - 1);
#pragma unroll
                        for (int bj = 0; bj < 2; ++bj) {
                            const int idx = bj == 0 ? (t >> 6) : (t & 63);
                            const f32x4 c = *(const f32x4*)(cosT + idx * 16 + 4 * fq), s = *(const f32x4*)(sinT + idx * 16 + 4 * fq);
                            const f32x4 x1 = x[bj][0], x2 = x[bj][1];
                            x[bj][0] = x1 * c - x2 * s; x[bj][1] = x1 * s + x2 * c;
                        }
                    }
                    if (isq) {
#pragma unroll
                        for (int bj = 0; bj < 2; ++bj)
#pragma unroll
                            for (int n = 0; n < 2; ++n) x[bj][n] = x[bj][n] * C2;
                    }
                }
                bf16_t* dst;
                if (isq) dst = Q + (size_t)(pm * 256 + rl) * AW + (4 * pn + wc) * 64;
                else {
                    const int b = latent ? (pm >> 3) : (pm - 64);
                    const int pos = latent ? (CTXL + ((pm * 256 + rl) & (SEQ - 1))) : rl;
                    dst = (isv ? VB : KB) + (size_t)(b * SKV + pos) * KVW + (wc & 1) * 64;
                }
#pragma unroll
                for (int bj = 0; bj < 2; ++bj)
#pragma unroll
                    for (int n = 0; n < 2; ++n) { const f32x4 v = x[bj][n]; u32x2 w; w.x = cvt_pk_bf16(v[0], v[1]); w.y = cvt_pk_bf16(v[2], v[3]); *(u32x2*)(dst + 32 * bj + 16 * n + 4 * fq) = w; }
            }
    }
};
struct EpiOut {
    const float* x; const float* mod; float* xnew;
    __device__ __forceinline__ void operator()(const f32x4 (&acc)[2][2][4][2], const Unit& u, int wr, int wc, int fr, int fq) const {
        const int b = u.pm >> 3;
#pragma unroll
        for (int bj = 0; bj < 2; ++bj)
#pragma unroll
            for (int n = 0; n < 2; ++n) {
                const int col = u.pn * 256 + bj * 128 + wc * 32 + n * 16 + 4 * fq;
                const f32x4 gt = *(const f32x4*)(mod + b * 6144 + 2048 + col);
#pragma unroll
                for (int ai = 0; ai < 2; ++ai)
#pragma unroll
                    for (int m = 0; m < 4; ++m) { const size_t off = (size_t)(u.pm * 256 + ai * 128 + wr * 64 + m * 16 + fr) * DM + col;
                        const f32x4 xs = *(const f32x4*)(x + off); *(f32x4*)(xnew + off) = xs + gt * acc[ai][bj][m][n]; }
            }
    }
};
__device__ __forceinline__ float silu_f(float g) { return g * __builtin_amdgcn_rcpf(1.0f + __builtin_amdgcn_exp2f(-1.4426950408889634f * g)); }
struct EpiUp {
    bf16_t* H;
    __device__ __forceinline__ void operator()(const f32x4 (&acc)[2][2][4][2], const Unit& u, int wr, int wc, int fr, int fq) const {
#pragma unroll
        for (int ai = 0; ai < 2; ++ai)
#pragma unroll
            for (int m = 0; m < 4; ++m) { bf16_t* rowp = H + (size_t)(u.pm * 256 + ai * 128 + wr * 64 + m * 16 + fr) * DE + u.pn * 128 + wc * 32 + 8 * fq;
                f32x4 h0, h1;
#pragma unroll
                for (int j = 0; j < 4; ++j) { h0[j] = silu_f(acc[ai][0][m][0][j]) * acc[ai][1][m][0][j]; h1[j] = silu_f(acc[ai][0][m][1][j]) * acc[ai][1][m][1][j]; }
                u32x4 w; w.x = cvt_pk_bf16(h0[0], h0[1]); w.y = cvt_pk_bf16(h0[2], h0[3]); w.z = cvt_pk_bf16(h1[0], h1[1]); w.w = cvt_pk_bf16(h1[2], h1[3]);
                *(u32x4*)rowp = w; }
    }
};
struct EpiDown {
    bf16_t* Y;
    __device__ __forceinline__ void operator()(const f32x4 (&acc)[2][2][4][2], const Unit& u, int wr, int wc, int fr, int fq) const {
#pragma unroll
        for (int ai = 0; ai < 2; ++ai)
#pragma unroll
            for (int m = 0; m < 4; ++m) { bf16_t* rowp = Y + (size_t)(u.pm * 256 + ai * 128 + wr * 64 + m * 16 + fr) * DM + u.pn * 256 + wc * 32 + 8 * fq;
#pragma unroll
                for (int bj = 0; bj < 2; ++bj) { const f32x4 v0 = acc[ai][bj][m][0], v1 = acc[ai][bj][m][1]; u32x4 w; w.x = cvt_pk_bf16(v0[0], v0[1]); w.y = cvt_pk_bf16(v0[2], v0[3]); w.z = cvt_pk_bf16(v1[0], v1[1]); w.w = cvt_pk_bf16(v1[2], v1[3]);
                    *(u32x4*)(rowp + bj * 128) = w; } }
    }
};
}

namespace attn_body {
using bf16 = __hip_bfloat16;
using bf16x8 = __attribute__((ext_vector_type(8))) short;
using s16x4 = __attribute__((ext_vector_type(4))) short;
using f32x16 = __attribute__((ext_vector_type(16))) float;
using u32x4 = __attribute__((ext_vector_type(4))) unsigned;
constexpr int D = 64, QP = AW  , KP = KVW  , OP = DM  ;
constexpr int NW = 8, QBLK = 32, QB = QBLK * NW, KVBLK = 64;
__device__ __forceinline__ int crow(int r, int hi) { return (r & 3) + 8 * (r >> 2) + 4 * hi; }
#define SBAR() __builtin_amdgcn_sched_barrier(0)
constexpr int NSLOT = 3, SLOTB = 8192;
constexpr int LDS_K = 0, LDS_V = NSLOT * SLOTB, LDS_WS = 2 * NSLOT * SLOTB, LDS_OST = LDS_WS + NW * 64 * 4, LDS_BYTES_A = LDS_OST + NW * 4096;
__device__ __forceinline__ void glds16(const void* gsrc, unsigned lds_dst) { unsigned keep;
  asm volatile("s_mov_b32 %0, m0\n\ts_mov_b32 m0, %2\n\ts_nop 0\n\tglobal_load_lds_dwordx4 %1, off\n\ts_mov_b32 m0, %0" : "=&s"(keep) : "v"(gsrc), "s"(lds_dst) : "memory"); }
__device__ __forceinline__ float max3f(float a, float b, float c) { float r; asm("v_max3_f32 %0, %1, %2, %3" : "=v"(r) : "v"(a), "v"(b), "v"(c)); return r; }
__device__ __forceinline__ float max2f(float a, float b) { float r; asm("v_max_f32_e32 %0, %1, %2" : "=v"(r) : "v"(a), "v"(b)); return r; }
__device__ __forceinline__ float fadd_s(float a, float b) { float r; asm("v_add_f32_e32 %0, %1, %2" : "=v"(r) : "v"(a), "v"(b)); return r; }
__device__ __forceinline__ float fsub_s(float a, float b) { float r; asm("v_sub_f32_e32 %0, %1, %2" : "=v"(r) : "v"(a), "v"(b)); return r; }
typedef float f32x2_t __attribute__((ext_vector_type(2))); typedef __bf16 bf16x2_t __attribute__((ext_vector_type(2)));
__device__ __forceinline__ unsigned cvtpk_s(float lo, float hi) { f32x2_t v = {lo, hi}; bf16x2_t b = __builtin_convertvector(v, bf16x2_t); return __builtin_bit_cast(unsigned, b); }
#define WAIT_BAR(N) asm volatile("s_waitcnt vmcnt(" #N ") lgkmcnt(0)\n\ts_barrier" ::: "memory")

__device__ __forceinline__ void qkt(f32x16& p0, f32x16& p1, const char* Kslot, const bf16x8* qr, const f32x16& negm, int r32, int hi) {
  const char* kb = Kslot + hi * 1024 + r32 * 16;
  #pragma unroll
  for (int d0 = 0; d0 < 4; ++d0) {
    const bf16x8 b0 = *reinterpret_cast<const bf16x8*>(kb + d0 * 2048);
    const bf16x8 b1 = *reinterpret_cast<const bf16x8*>(kb + d0 * 2048 + 512);
    if (d0 == 0) { p0 = __builtin_amdgcn_mfma_f32_32x32x16_bf16(b0, qr[0], negm, 0, 0, 0); p1 = __builtin_amdgcn_mfma_f32_32x32x16_bf16(b1, qr[0], negm, 0, 0, 0); }
    else { p0 = __builtin_amdgcn_mfma_f32_32x32x16_bf16(b0, qr[d0], p0, 0, 0, 0); p1 = __builtin_amdgcn_mfma_f32_32x32x16_bf16(b1, qr[d0], p1, 0, 0, 0); } }
}
typedef __attribute__((address_space(3))) const char* lds_cptr;
typedef short v4i16_t __attribute__((ext_vector_type(4)));
__device__ __forceinline__ void kload8(bf16x8* kf, lds_cptr kp) {
  kf[0] = *(const __attribute__((address_space(3))) bf16x8*)(kp);        kf[1] = *(const __attribute__((address_space(3))) bf16x8*)(kp + 512);
  kf[2] = *(const __attribute__((address_space(3))) bf16x8*)(kp + 2048); kf[3] = *(const __attribute__((address_space(3))) bf16x8*)(kp + 2560);
  kf[4] = *(const __attribute__((address_space(3))) bf16x8*)(kp + 4096); kf[5] = *(const __attribute__((address_space(3))) bf16x8*)(kp + 4608);
  kf[6] = *(const __attribute__((address_space(3))) bf16x8*)(kp + 6144); kf[7] = *(const __attribute__((address_space(3))) bf16x8*)(kp + 6656);
}
__device__ __forceinline__ void kload2(bf16x8* kf, lds_cptr kp, int j) { kf[2 * j] = *(const __attribute__((address_space(3))) bf16x8*)(kp + j * 2048); kf[2 * j + 1] = *(const __attribute__((address_space(3))) bf16x8*)(kp + j * 2048 + 512); }
__device__ __forceinline__ s16x4 vtr(lds_cptr p) { return __builtin_bit_cast(s16x4, __builtin_amdgcn_ds_read_tr16_b64_v4i16((__attribute__((address_space(3))) v4i16_t*)p)); }
__device__ __forceinline__ float rowmax(const f32x16& p0, const f32x16& p1) {
  float a = max3f(p0[0], p0[1], p1[0]), b = max3f(p0[2], p0[3], p1[1]); a = max3f(a, p1[2], p1[3]);
  #pragma unroll
  for (int r = 4; r < 16; r += 4) { a = max3f(a, p0[r], p0[r + 1]); b = max3f(b, p0[r + 2], p0[r + 3]); a = max3f(a, p1[r], p1[r + 1]); b = max3f(b, p1[r + 2], p1[r + 3]); }
  const float m = max2f(a, b);
  auto rr = __builtin_amdgcn_permlane32_swap(__float_as_uint(m), __float_as_uint(m), false, false);
  return max2f(__uint_as_float(rr[0]), __uint_as_float(rr[1]));
}
__device__ __forceinline__ void pv(f32x16* o, int vb, bf16x8 pa0, bf16x8 pa1, bf16x8 pa2, bf16x8 pa3) {
  #pragma unroll
  for (int d0 = 0; d0 < 2; ++d0) { s16x4 lo[4], hi[4];
    #pragma unroll
    for (int ks = 0; ks < 4; ++ks) {
      asm volatile("ds_read_b64_tr_b16 %0,%1 offset:%c2" : "=&v"(lo[ks]) : "v"(vb), "i"(d0 * 4096 + ks * 1024) : "memory");
      asm volatile("ds_read_b64_tr_b16 %0,%1 offset:%c2" : "=&v"(hi[ks]) : "v"(vb), "i"(d0 * 4096 + ks * 1024 + 512) : "memory"); }
    asm volatile("s_waitcnt lgkmcnt(0)" ::: "memory"); SBAR();
    #define PK(k) (bf16x8){lo[k][0], lo[k][1], lo[k][2], lo[k][3], hi[k][0], hi[k][1], hi[k][2], hi[k][3]}
    o[d0] = __builtin_amdgcn_mfma_f32_32x32x16_bf16(pa0, PK(0), o[d0], 0, 0, 0);
    o[d0] = __builtin_amdgcn_mfma_f32_32x32x16_bf16(pa1, PK(1), o[d0], 0, 0, 0);
    o[d0] = __builtin_amdgcn_mfma_f32_32x32x16_bf16(pa2, PK(2), o[d0], 0, 0, 0);
    o[d0] = __builtin_amdgcn_mfma_f32_32x32x16_bf16(pa3, PK(3), o[d0], 0, 0, 0);
    #undef PK
  }
}

template <int THRL> __device__ __forceinline__ void attn_unit(int b, int h, int qb, const bf16* Q, const bf16* __restrict__ K, const bf16* __restrict__ V, bf16* O, const float* og, char* shm) {
  int tid = threadIdx.x; asm volatile("" : "+v"(tid));
  const int lane = tid & 63, r32 = lane & 31, hi = lane >> 5; const int wid = __builtin_amdgcn_readfirstlane(tid >> 6);
  const int q0 = qb * QB; const int kvh = h >> 2;
  const bf16* Qw = Q + ((long)b * SEQ + q0 + wid * QBLK) * QP + h * D;
  const bf16 *Kh = K + (long)b * SKV * KP + kvh * D, *Vh = V + (long)b * SKV * KP + kvh * D;
  const unsigned lds0 = (unsigned)(uintptr_t)shm;
  float* wsf = (float*)(shm + LDS_WS) + wid * 64;
  const bf16* ksrc = Kh + (long)lane * KP + wid * 8;
  const bf16* vsrc = Vh + (long)(16 * (wid & 3) + (lane >> 2)) * KP + (wid >> 2) * 32 + (lane & 3) * 8;
  const unsigned kdst = lds0 + LDS_K + wid * 1024, vdst = lds0 + LDS_V + wid * 1024;
  #define DMA_K(t, slot) glds16(ksrc + (long)(t) * KVBLK * KP, (unsigned)__builtin_amdgcn_readfirstlane(kdst + (slot)))
  #define DMA_V(t, slot) glds16(vsrc + (long)(t) * KVBLK * KP, (unsigned)__builtin_amdgcn_readfirstlane(vdst + (slot)))
  const int vb0 = (int)(lds0 + LDS_V) + ((lane >> 4) & 1) * 32 + (lane & 3) * 8 + (4 * hi + ((lane & 15) >> 2)) * 64;
  const char* Kbase = shm + LDS_K; bf16x8 kf[8];
  const lds_cptr shm3 = (lds_cptr)shm; const lds_cptr kp0 = shm3 + LDS_K + hi * 1024 + r32 * 16; const lds_cptr vp0 = shm3 + LDS_V + ((lane >> 4) & 1) * 32 + (lane & 3) * 8 + (4 * hi + ((lane & 15) >> 2)) * 64;
  constexpr int NT = SKV / KVBLK;
  DMA_K(0, 0); DMA_V(0, 0); DMA_K(1, SLOTB);
  bf16x8 qr[4];
  #pragma unroll
  for (int d0 = 0; d0 < 4; ++d0) qr[d0] = *reinterpret_cast<const bf16x8*>(&Qw[(long)r32 * QP + d0 * 16 + hi * 8]);
  float mhat = 0.f, l_reg = 0.f; f32x16 o[2]; o[0] = f32x16{}; o[1] = f32x16{}; f32x16 negm = f32x16{}; asm volatile("" : "+v"(negm));
  bool resc = false;
  #define START(P0, P1) do { const float rm = rowmax(P0, P1); resc = false; \
    { const float dl = rm; mhat = fadd_s(mhat, dl); \
      _Pragma("unroll") for (int r = 0; r < 16; ++r) { P0[r] = fsub_s(P0[r], dl); P1[r] = fsub_s(P1[r], dl); } \
      _Pragma("unroll") for (int r = 0; r < 16; ++r) negm[r] = -mhat; asm volatile("" : "+v"(negm)); } \
    _Pragma("unroll") for (int r = 0; r < 16; ++r) P0[r] = __builtin_amdgcn_exp2f(P0[r]); } while (0)
  #define RESC() do { if (resc) { asm volatile("s_waitcnt lgkmcnt(0)" ::: "memory"); \
      _Pragma("unroll") for (int d_ = 0; d_ < 2; ++d_) _Pragma("unroll") for (int r = 0; r < 16; ++r) o[d_][r] *= wsf[crow(r, hi)]; } } while (0)
  f32x16 pA0, pA1, pB0, pB1;
  int sl_prev = 0, sl_cur = 0, sl_next = SLOTB;
  #define ROT() do { sl_prev = sl_cur; sl_cur = sl_next; sl_next = (sl_next == (NSLOT - 1) * SLOTB) ? 0 : sl_next + SLOTB; } while (0)
  DMA_K(2, 2 * SLOTB);
  WAIT_BAR(3);
  qkt(pA0, pA1, Kbase, qr, negm, r32, hi); asm volatile("s_nop 15\n\ts_nop 7" : "+v"(pA0), "+v"(pA1));
  START(pA0, pA1);
  _Pragma("unroll") for (int r = 0; r < 16; ++r) pA1[r] = __builtin_amdgcn_exp2f(pA1[r]);
  WAIT_BAR(0);
  DMA_K(3, 0); DMA_V(1, SLOTB);
  ROT();
  kload8(kf, kp0 + sl_cur);
  WAIT_BAR(2);
  s16x4 vlo[8], vhi[8]; u32x4 pw0, pw1, pw2, pw3;
  #define PKW(P, B) cvtpk_s(P[B], P[B + 1])
  #define PAF(k) __builtin_bit_cast(bf16x8, pw##k)
  #define VFR(i) (bf16x8){vlo[i][0], vlo[i][1], vlo[i][2], vlo[i][3], vhi[i][0], vhi[i][1], vhi[i][2], vhi[i][3]}
  #define PIN(x) asm volatile("" : "+v"(x))
  #define MX3(a, b, c) __builtin_fmaxf(__builtin_fmaxf((a), (b)), (c))
  #define GAPA(MF, A0, A1, A2, A3, W0, W1, PW) do { MF; sacc += A0; sacc += A1; sacc += A2; sacc += A3; PIN(sacc); W0; W1; PIN(PW); SBAR(); } while (0)
  #define EX(v) __builtin_amdgcn_exp2f(v)
  #define GAPB(MF, X, B) do { MF; X[B] = EX(X[B]); X[B + 1] = EX(X[B + 1]); X[B + 2] = EX(X[B + 2]); X[B + 3] = EX(X[B + 3]); PIN(X); SBAR(); } while (0)
  #define VRD(i) do { vlo[i] = vtr(vp_ + (((i) >> 2) * 4096 + ((i) & 3) * 1024)); vhi[i] = vtr(vp_ + (((i) >> 2) * 4096 + ((i) & 3) * 1024 + 512)); } while (0)
  #define KRD(G, j) do { if (G) { kload2(kf, kp0 + sl_next, j); SBAR(); } } while (0)
  #define STEP(C0, C1, P0, P1, t, GK, GV, GL) do { SBAR(); \
    const lds_cptr vp_ = vp0 + sl_prev; \
    VRD(0); SBAR(); float sacc = (P0[0] + P0[1]); \
    GAPA(C0 = __builtin_amdgcn_mfma_f32_32x32x16_bf16(kf[0], qr[0], negm, 0, 0, 0), P0[2], P0[3], P0[4], P0[5],     pw0[0] = PKW(P0, 0), pw0[1] = PKW(P0, 2), pw0); \
    VRD(4); SBAR(); GAPA(C1 = __builtin_amdgcn_mfma_f32_32x32x16_bf16(kf[1], qr[0], negm, 0, 0, 0), P0[6], P0[7], P0[8], P0[9],     pw0[2] = PKW(P0, 4), pw0[3] = PKW(P0, 6), pw0); \
    VRD(1); SBAR(); GAPA(C0 = __builtin_amdgcn_mfma_f32_32x32x16_bf16(kf[2], qr[1], C0, 0, 0, 0),   P0[10], P0[11], P0[12], P0[13], pw1[0] = PKW(P0, 8), pw1[1] = PKW(P0, 10), pw1); \
    VRD(5); SBAR(); GAPA(C1 = __builtin_amdgcn_mfma_f32_32x32x16_bf16(kf[3], qr[1], C1, 0, 0, 0),   P0[14], P0[15], P1[0], P1[1],   pw1[2] = PKW(P0, 12), pw1[3] = PKW(P0, 14), pw1); \
    VRD(2); SBAR(); GAPA(C0 = __builtin_amdgcn_mfma_f32_32x32x16_bf16(kf[4], qr[2], C0, 0, 0, 0),   P1[2], P1[3], P1[4], P1[5],     pw2[0] = PKW(P1, 0), pw2[1] = PKW(P1, 2), pw2); \
    VRD(6); SBAR(); GAPA(C1 = __builtin_amdgcn_mfma_f32_32x32x16_bf16(kf[5], qr[2], C1, 0, 0, 0),   P1[6], P1[7], P1[8], P1[9],     pw2[2] = PKW(P1, 4), pw2[3] = PKW(P1, 6), pw2); \
    VRD(3); SBAR(); GAPA(C0 = __builtin_amdgcn_mfma_f32_32x32x16_bf16(kf[6], qr[3], C0, 0, 0, 0),   P1[10], P1[11], P1[12], P1[13], pw3[0] = PKW(P1, 8), pw3[1] = PKW(P1, 10), pw3); \
    VRD(7); SBAR(); GAPA(C1 = __builtin_amdgcn_mfma_f32_32x32x16_bf16(kf[7], qr[3], C1, 0, 0, 0),   P1[14], P1[15], 0.f, 0.f,       pw3[2] = PKW(P1, 12), pw3[3] = PKW(P1, 14), pw3); \
    l_reg += sacc; \
    if (GK) { DMA_K((t) + 3, sl_cur); } if (GV) { DMA_V((t) + 1, sl_next); } \
    { float a = MX3(C0[0], C0[1], C1[0]), b_ = MX3(C0[2], C0[3], C1[1]); a = MX3(a, C1[2], C1[3]); \
      _Pragma("unroll") for (int r = 4; r < 16; r += 4) { a = MX3(a, C0[r], C0[r + 1]); b_ = MX3(b_, C0[r + 2], C0[r + 3]); a = MX3(a, C1[r], C1[r + 1]); b_ = MX3(b_, C1[r + 2], C1[r + 3]); } \
      float rm = __builtin_fmaxf(a, b_); { auto rr = __builtin_amdgcn_permlane32_swap(__float_as_uint(rm), __float_as_uint(rm), false, false); rm = __builtin_fmaxf(__uint_as_float(rr[0]), __uint_as_float(rr[1])); } \
      resc = false; \
      if (__builtin_expect(__any(rm > (float)THRL), 0)) { const float dl = __builtin_fmaxf(rm, 0.f); mhat += dl; \
        _Pragma("unroll") for (int r = 0; r < 16; ++r) { C0[r] -= dl; C1[r] -= dl; } \
        _Pragma("unroll") for (int r = 0; r < 16; ++r) negm[r] = -mhat; asm volatile("" : "+v"(negm)); \
        const float f = __builtin_amdgcn_exp2f(-dl); l_reg *= f; if (hi == 0) wsf[r32] = f; resc = true; } } \
    SBAR(); \
    GAPB(o[0] = __builtin_amdgcn_mfma_f32_32x32x16_bf16(PAF(0), VFR(0), o[0], 0, 0, 0), C0, 0); \
    GAPB(o[1] = __builtin_amdgcn_mfma_f32_32x32x16_bf16(PAF(0), VFR(4), o[1], 0, 0, 0), C0, 4); \
    KRD(GL, 0); GAPB(o[0] = __builtin_amdgcn_mfma_f32_32x32x16_bf16(PAF(1), VFR(1), o[0], 0, 0, 0), C0, 8); \
    KRD(GL, 1); GAPB(o[1] = __builtin_amdgcn_mfma_f32_32x32x16_bf16(PAF(1), VFR(5), o[1], 0, 0, 0), C0, 12); \
    KRD(GL, 2); GAPB(o[0] = __builtin_amdgcn_mfma_f32_32x32x16_bf16(PAF(2), VFR(2), o[0], 0, 0, 0), C1, 0); \
    KRD(GL, 3); GAPB(o[1] = __builtin_amdgcn_mfma_f32_32x32x16_bf16(PAF(2), VFR(6), o[1], 0, 0, 0), C1, 4); \
    GAPB(o[0] = __builtin_amdgcn_mfma_f32_32x32x16_bf16(PAF(3), VFR(3), o[0], 0, 0, 0), C1, 8); \
    GAPB(o[1] = __builtin_amdgcn_mfma_f32_32x32x16_bf16(PAF(3), VFR(7), o[1], 0, 0, 0), C1, 12); \
    } while (0)
  int t = 1;
  for (; t + 5 < NT; t += 2) {
    STEP(pB0, pB1, pA0, pA1, t, true, true, true);     WAIT_BAR(2); RESC(); ROT();
    STEP(pA0, pA1, pB0, pB1, t + 1, true, true, true); WAIT_BAR(2); RESC(); ROT();
  }
  #define ENDW(tt) do { if ((tt) + 3 < NT) { WAIT_BAR(2); } else if ((tt) + 2 < NT) { WAIT_BAR(1); } else { WAIT_BAR(0); } } while (0)
  for (; t + 1 < NT; t += 2) {
    STEP(pB0, pB1, pA0, pA1, t, (t + 3 < NT), (t + 1 < NT), (t + 1 < NT));         ENDW(t);     RESC(); ROT();
    STEP(pA0, pA1, pB0, pB1, t + 1, (t + 4 < NT), (t + 2 < NT), (t + 2 < NT));     ENDW(t + 1); RESC(); ROT();
  }
  STEP(pB0, pB1, pA0, pA1, NT - 1, false, false, false); RESC();
  { float sacc = pB0[0] + pB0[1]; _Pragma("unroll") for (int r = 2; r < 16; ++r) sacc += pB0[r]; _Pragma("unroll") for (int r = 0; r < 16; ++r) sacc += pB1[r]; l_reg += sacc;
    pw0 = (u32x4){PKW(pB0, 0), PKW(pB0, 2), PKW(pB0, 4), PKW(pB0, 6)}; pw1 = (u32x4){PKW(pB0, 8), PKW(pB0, 10), PKW(pB0, 12), PKW(pB0, 14)}; pw2 = (u32x4){PKW(pB1, 0), PKW(pB1, 2), PKW(pB1, 4), PKW(pB1, 6)}; pw3 = (u32x4){PKW(pB1, 8), PKW(pB1, 10), PKW(pB1, 12), PKW(pB1, 14)};
    SBAR(); pv(o, vb0 + sl_cur, PAF(0), PAF(1), PAF(2), PAF(3)); }
  #undef PKW
  #undef PAF
  #undef VFR
  #undef PIN
  #undef MX3
  #undef GAPA
  #undef GAPB
  #undef EX
  #undef VRD
  #undef KRD
  #undef STEP
  #undef ENDW
  { auto rr = __builtin_amdgcn_permlane32_swap(__float_as_uint(l_reg), __float_as_uint(l_reg), false, false); l_reg = __uint_as_float(rr[0]) + __uint_as_float(rr[1]); }
  if (hi == 0) wsf[32 + r32] = l_reg; asm volatile("s_waitcnt lgkmcnt(0)" ::: "memory");
  float rli[16];
  #pragma unroll
  for (int r = 0; r < 16; ++r) rli[r] = __builtin_amdgcn_rcpf(wsf[32 + crow(r, hi)]);
  bf16* Ow = O + ((long)b * SEQ + q0 + wid * QBLK) * OP + h * D;
  { bf16* stg = (bf16*)(shm + LDS_OST) + wid * 2048;
    #pragma unroll
    for (int r = 0; r < 16; ++r) { const int orow = crow(r, hi);
      #pragma unroll
      for (int d0 = 0; d0 < 2; ++d0) stg[orow * 64 + d0 * 32 + r32] = __float2bfloat16(o[d0][r] * rli[r]); }
    asm volatile("s_waitcnt lgkmcnt(0)" ::: "memory");
    const int ch = lane & 7;
    const f32x4 g0 = *(const f32x4*)(og + h * D + ch * 8), g1 = *(const f32x4*)(og + h * D + ch * 8 + 4);
    #pragma unroll
    for (int i = 0; i < 4; ++i) { const int row = i * 8 + (lane >> 3); const u32x4 v = *(const u32x4*)(stg + row * 64 + ch * 8);
      float f[8]; f[0] = bf_lo(v.x); f[1] = bf_hi(v.x); f[2] = bf_lo(v.y); f[3] = bf_hi(v.y); f[4] = bf_lo(v.z); f[5] = bf_hi(v.z); f[6] = bf_lo(v.w); f[7] = bf_hi(v.w);
      float ss = 0.f;
      #pragma unroll
      for (int j = 0; j < 8; ++j) ss += f[j] * f[j];
      ss += __shfl_xor(ss, 1); ss += __shfl_xor(ss, 2); ss += __shfl_xor(ss, 4);
      const float rstd = 1.0f / sqrtf(ss * (1.0f / 64.0f) + EPS);
      u32x4 w; w.x = cvtpk_s(f[0] * rstd * g0[0], f[1] * rstd * g0[1]); w.y = cvtpk_s(f[2] * rstd * g0[2], f[3] * rstd * g0[3]); w.z = cvtpk_s(f[4] * rstd * g1[0], f[5] * rstd * g1[1]); w.w = cvtpk_s(f[6] * rstd * g1[2], f[7] * rstd * g1[3]);
      *(u32x4*)(Ow + (long)row * OP + ch * 8) = w; } }
  asm volatile("s_waitcnt lgkmcnt(0)\n\ts_barrier" ::: "memory");
  #undef DMA_K
  #undef DMA_V
  #undef START
  #undef RESC
  #undef ROT
}
#undef SBAR
#undef WAIT_BAR
}

#define XB_TMO      128
#define XB_XCNT(j)  (256  + 64 * (j))
#define XB_XSUB(j)  (1280 + 64 * (j))
#define XB_XGEN(j)  (2304 + 64 * (j))
#define XB_TOP      3328
#define XB_TOPGEN   3392
#define XCD_BAR_WORDS 3456
#define XB_SPIN_CAP (1u << 18)
__device__ __forceinline__ unsigned xb_ld(unsigned* p)              { return __hip_atomic_load(p, __ATOMIC_RELAXED, __HIP_MEMORY_SCOPE_AGENT); }
__device__ __forceinline__ unsigned xb_add(unsigned* p, unsigned v) { return __hip_atomic_fetch_add(p, v, __ATOMIC_RELAXED, __HIP_MEMORY_SCOPE_AGENT); }
__device__ __forceinline__ unsigned xb_xcc_id() { return (unsigned)__builtin_amdgcn_s_getreg((3 << 11) | 20) & 0xFu; }
#define XB_SPIN(cond, bar) do { unsigned _sp = 0; while (cond) { __builtin_amdgcn_s_sleep(1); \
    if ((++_sp & 255u) == 0u) { if (xb_ld(&(bar)[XB_TMO])) break; if (_sp > XB_SPIN_CAP) { atomicAdd(&(bar)[XB_TMO], 1u); break; } } } } while (0)
struct XcdBarrier { unsigned* bar; unsigned x; volatile LAS unsigned* st; };
__device__ __forceinline__ XcdBarrier xcd_barrier_post(unsigned* bar, volatile LAS unsigned* st) {
    XcdBarrier b; b.bar = bar; b.x = xb_xcc_id(); b.st = st;
    if (threadIdx.x == 0) (void)xb_add(&bar[XB_XCNT(b.x)], 1u);
    return b;
}
__device__ __forceinline__ void xcd_barrier_complete(unsigned* bar, unsigned x, unsigned& nloc, unsigned& nx) {
    const unsigned G = gridDim.x * gridDim.y * gridDim.z;
    unsigned sum, cnt, mine, sp = 0u;
    for (;;) {
        sum = 0u; cnt = 0u; mine = 0u;
#pragma unroll
        for (unsigned j = 0; j < 16; ++j) { const unsigned c = xb_ld(&bar[XB_XCNT(j)]); sum += c; cnt += (c > 0u) ? 1u : 0u; mine = (j == x) ? c : mine; }
        if (sum == G) break;
        __builtin_amdgcn_s_sleep(1);
        if ((++sp & 255u) == 0u) { if (xb_ld(&bar[XB_TMO])) break; if (sp > XB_SPIN_CAP) { atomicAdd(&bar[XB_TMO], 1u); break; } }
    }
    nloc = mine > 0u ? mine : 1u; nx = cnt > 0u ? cnt : 1u;
}
__device__ __forceinline__ void xcd_barrier(const XcdBarrier& b) {
    asm volatile("s_waitcnt vmcnt(0)" ::: "memory");
    __syncthreads();
    if (threadIdx.x == 0) {
        unsigned* bar = b.bar;
        __builtin_amdgcn_s_waitcnt(0);
        unsigned nloc = b.st[0], nx = b.st[1];
        if (nloc == 0u) { xcd_barrier_complete(bar, b.x, nloc, nx); b.st[0] = nloc; b.st[1] = nx; }
        const unsigned old = xb_add(&bar[XB_XSUB(b.x)], 1u);
        const unsigned gen = old / nloc;
        if (old + 1u == (gen + 1u) * nloc) {
            __builtin_amdgcn_fence(__ATOMIC_RELEASE, "agent");
            asm volatile("s_waitcnt vmcnt(0)" ::: "memory");
            const unsigned og = xb_add(&bar[XB_TOP], 1u);
            const unsigned tg = og / nx;
            if (og + 1u == (tg + 1u) * nx) xb_add(&bar[XB_TOPGEN], 1u);
            else XB_SPIN(xb_ld(&bar[XB_TOPGEN]) == tg, bar);
            __builtin_amdgcn_fence(__ATOMIC_ACQUIRE, "agent");
            xb_add(&bar[XB_XGEN(b.x)], 1u);
            asm volatile("s_waitcnt vmcnt(0)" ::: "memory");
        } else {
            XB_SPIN(xb_ld(&bar[XB_XGEN(b.x)]) == gen, bar);
            __builtin_amdgcn_fence(__ATOMIC_ACQUIRE, "agent");
            asm volatile("s_waitcnt vmcnt(0)" ::: "memory");
        }
    }
    __syncthreads();
}

struct Args {
    const float *x, *c, *ctx, *c_ctx, *w_mod, *b_mod, *norm1_g, *w_in, *q_g, *k_g, *conv_w, *attn_g, *conv_g, *w_out, *norm2_g, *w_group, *w_router, *w_gate, *w_up, *w_down, *final_g;
    float* out; unsigned char* ws; int ph_lo, ph_hi;
};

template <class RowMap>
__device__ __forceinline__ void transpose_item(const float* __restrict__ W, int K, int N, bf16_t* WT, LAS float* scr, int k0, int n0, int lane, RowMap rm) {
    f32x4 v[16];
#pragma unroll
    for (int i = 0; i < 16; ++i) { const int kk = 4 * i + (lane >> 4); v[i] = *(const f32x4*)(W + (size_t)(k0 + kk) * N + n0 + 4 * (lane & 15)); }
#pragma unroll
    for (int i = 0; i < 16; ++i) { const int kk = 4 * i + (lane >> 4); LAS float* p = scr + kk * 65 + 4 * (lane & 15); p[0] = v[i][0]; p[1] = v[i][1]; p[2] = v[i][2]; p[3] = v[i][3]; }
    asm volatile("s_waitcnt lgkmcnt(0)" ::: "memory");
    const int c = lane & 7;
#pragma unroll
    for (int j = 0; j < 8; ++j) { const int n = 8 * j + (lane >> 3); const LAS float* s = scr + (8 * c) * 65 + n;
        u32x4 o; o.x = cvt_pk_bf16(s[0 * 65], s[1 * 65]); o.y = cvt_pk_bf16(s[2 * 65], s[3 * 65]); o.z = cvt_pk_bf16(s[4 * 65], s[5 * 65]); o.w = cvt_pk_bf16(s[6 * 65], s[7 * 65]);
        *(u32x4*)(WT + (size_t)rm(n0 + n) * K + k0 + 8 * c) = o; }
    asm volatile("s_waitcnt lgkmcnt(0)" ::: "memory");
}
struct MapWin { __device__ __forceinline__ int operator()(int n) const { return drow_win(n); } };
struct MapId  { __device__ __forceinline__ int operator()(int n) const { return n; } };
struct MapGU  { int up; __device__ __forceinline__ int operator()(int n) const { return drow_gu(n, up); } };
struct MapDn  { __device__ __forceinline__ int operator()(int n) const { return drow_dn(n); } };

__device__ __forceinline__ void sincos_small(double a, double& s, double& c) {
    const double n = rint(a * 0.63661977236758134308);
    double r = fma(-n, 1.57079632679489655800, a); r = fma(-n, 6.12323399573676603587e-17, r);
    const double r2 = r * r;
    double sp = -7.6471637318198164759e-13;
    sp = fma(sp, r2, 1.6059043836821614599e-10);
    sp = fma(sp, r2, -2.5052108385441718775e-08);
    sp = fma(sp, r2, 2.7557319223985890653e-06);
    sp = fma(sp, r2, -1.9841269841269841270e-04);
    sp = fma(sp, r2, 8.3333333333333333333e-03);
    sp = fma(sp, r2, -1.6666666666666666667e-01);
    sp = fma(sp * r2, r, r);
    double cp = 4.7794773323873852974e-14;
    cp = fma(cp, r2, -1.1470745597729724714e-11);
    cp = fma(cp, r2, 2.0876756987868098979e-09);
    cp = fma(cp, r2, -2.7557319223985890653e-07);
    cp = fma(cp, r2, 2.4801587301587301587e-05);
    cp = fma(cp, r2, -1.3888888888888888889e-03);
    cp = fma(cp, r2, 4.1666666666666666667e-02);
    cp = fma(cp, r2, -0.5);
    cp = fma(cp, r2, 1.0);
    const int q = ((int)n) & 3;
    s = (q == 0) ? sp : (q == 1) ? cp : (q == 2) ? -sp : -cp;
    c = (q == 0) ? cp : (q == 1) ? -sp : (q == 2) ? -cp : sp;
}

__global__ void __launch_bounds__(512, 2) mk_fwd(Args A) {
    extern __shared__ __attribute__((aligned(16))) unsigned char lds_raw[];
    LAS unsigned char* lds = (LAS unsigned char*)lds_raw;
    const int G = gridDim.x, bx = blockIdx.x;
    const int vcu = (G % 8 == 0) ? (bx % 8) * (G / 8) + bx / 8 : bx;
    gu32* ctl = (gu32*)(A.ws + WS_CTL);
    const int NGW = G * 8;
#define PHASE_IDS() int tid = threadIdx.x; asm volatile("" : "+v"(tid)); const int lane = tid & 63, wave = __builtin_amdgcn_readfirstlane(tid >> 6); const int gw = vcu * 8 + wave; (void)gw; (void)lane
#define WSP(T, off) ((T*)(A.ws + (off)))
    { PHASE_IDS(); for (int u = tid; u < (LDS_BYTES - MISC_OFF) / 4; u += 512) ((LAS unsigned*)(lds + MISC_OFF))[u] = 0u; }
    __syncthreads();
    XcdBarrier bar; bar.bar = (unsigned*)(ctl + CW_BAR); bar.x = 0; bar.st = nullptr;
    if (MK_N_LAUNCHES == 1) bar = xcd_barrier_post((unsigned*)(ctl + CW_BAR), (volatile LAS unsigned*)(lds + MISC_OFF) + 8);
    const int lo = A.ph_lo, hi = A.ph_hi;
#define IN(k) (lo <= (k) && (k) < hi)
#define SEAM(k) do { if (IN(k) && IN((k) + 1)) xcd_barrier(bar); } while (0)

    if (IN(0)) {
        PHASE_IDS();
        float* MOD = WSP(float, WS_MOD); float* COS_T = WSP(float, WS_ROPE); float* SIN_T = COS_T + 1024;
        bf16_t* WIN_T = WSP(bf16_t, WS_WIN); bf16_t* WOUT_T = WSP(bf16_t, WS_WOUT); bf16_t* WUP_T = WSP(bf16_t, WS_WUP); bf16_t* WDN_T = WSP(bf16_t, WS_WDN);
        if (bx < 192) {
            LAS float* sc = (LAS float*)lds;
            for (int i = tid; i < 9 * 1024; i += 512) { const int b = i >> 10, k = i & 1023; const float v = (b < 8) ? A.c[b * 1024 + k] : A.c_ctx[k]; sc[i] = v / (1.0f + expf(-v)); }
            __syncthreads();
            const int col = 32 * bx + (lane & 31), kh = lane >> 5;
            float a0 = 0.f, a1 = 0.f, a2 = 0.f, a3 = 0.f, a4 = 0.f, a5 = 0.f, a6 = 0.f, a7 = 0.f, a8 = 0.f;
#pragma unroll 8
            for (int it = 0; it < 64; ++it) { const int k = 128 * wave + 2 * it + kh; const float w = A.w_mod[(size_t)k * 6144 + col];
                a0 += sc[k] * w; a1 += sc[1024 + k] * w; a2 += sc[2048 + k] * w; a3 += sc[3072 + k] * w; a4 += sc[4096 + k] * w; a5 += sc[5120 + k] * w; a6 += sc[6144 + k] * w; a7 += sc[7168 + k] * w; a8 += sc[8192 + k] * w; }
            a0 += __shfl_xor(a0, 32); a1 += __shfl_xor(a1, 32); a2 += __shfl_xor(a2, 32); a3 += __shfl_xor(a3, 32); a4 += __shfl_xor(a4, 32); a5 += __shfl_xor(a5, 32); a6 += __shfl_xor(a6, 32); a7 += __shfl_xor(a7, 32); a8 += __shfl_xor(a8, 32);
            LAS float* part = sc + 9 * 1024;
            if (lane < 32) { LAS float* p = part + wave * 288 + lane; p[0] = a0; p[32] = a1; p[64] = a2; p[96] = a3; p[128] = a4; p[160] = a5; p[192] = a6; p[224] = a7; p[256] = a8; }
            __syncthreads();
            if (tid < 288) { const int b = tid >> 5, cc = tid & 31; float s = 0.f;
#pragma unroll
                for (int w = 0; w < 8; ++w) s += part[w * 288 + b * 32 + cc];
                MOD[b * 6144 + 32 * bx + cc] = s + A.b_mod[32 * bx + cc]; }
            __syncthreads();
        }
        if (bx == G - 1) {
            for (int i = tid; i < 1024; i += 512) { const int idx = i >> 4, f = i & 15; double inv = 1.0; for (int j = 0; j < f; ++j) inv *= 0.56234132519034908039;
                double s, c; sincos_small((double)idx * inv, s, c); COS_T[i] = (float)c; SIN_T[i] = (float)s; }
        }
        {
            LAS float* scr = (LAS float*)(lds + wave * 16640);
            constexpr int I_IN = 16 * 36, I_OUT = 16 * 16, I_G = 16 * 12, I_D = 12 * 16, I_E = 2 * I_G + I_D;
            constexpr int NITEMS = I_IN + I_OUT + NE * I_E;
            for (int it = gw; it < NITEMS; it += NGW) {
                int r = it;
                if (r < I_IN) { transpose_item(A.w_in, DM, NCOLS, WIN_T, scr, 64 * (r / 36), 64 * (r % 36), lane, MapWin{}); continue; } r -= I_IN;
                if (r < I_OUT) { transpose_item(A.w_out, DM, DM, WOUT_T, scr, 64 * (r / 16), 64 * (r % 16), lane, MapId{}); continue; } r -= I_OUT;
                const int e = r / I_E; r -= e * I_E;
                if (r < I_G) { transpose_item(A.w_gate + (size_t)e * DM * DE, DM, DE, WUP_T + (size_t)e * NUP * DM, scr, 64 * (r / 12), 64 * (r % 12), lane, MapGU{0}); continue; } r -= I_G;
                if (r < I_G) { transpose_item(A.w_up + (size_t)e * DM * DE, DM, DE, WUP_T + (size_t)e * NUP * DM, scr, 64 * (r / 12), 64 * (r % 12), lane, MapGU{1}); continue; } r -= I_G;
                transpose_item(A.w_down + (size_t)e * DE * DM, DE, DM, WDN_T + (size_t)e * DM * DE, scr, 64 * (r / 16), 64 * (r % 16), lane, MapDn{});
            }
        }
    }
    SEAM(0);

    if (IN(1)) {
        PHASE_IDS();
        const float* MOD = WSP(float, WS_MOD); bf16_t* HX = WSP(bf16_t, WS_HX);
        for (int m = gw; m < MROWS; m += NGW) {
            const bool lat = m < NTOK; const int b = lat ? (m >> 11) : 8;
            const float* xrow = lat ? (A.x + (size_t)m * DM) : (A.ctx + (size_t)(m - NTOK) * DM);
            const float* md = MOD + b * 6144;
            f32x4 v[4]; float s = 0.f;
#pragma unroll
            for (int j = 0; j < 4; ++j) { v[j] = *((const f32x4*)xrow + lane + 64 * j); s += (v[j][0] * v[j][0] + v[j][1] * v[j][1]) + (v[j][2] * v[j][2] + v[j][3] * v[j][3]); }
            const float rstd = 1.0f / sqrtf(wave_sum(s) * (1.0f / DM) + EPS);
#pragma unroll
            for (int j = 0; j < 4; ++j) { const int col = 4 * lane + 256 * j;
                const f32x4 g = *(const f32x4*)(A.norm1_g + col), sh = *(const f32x4*)(md + col), sc = *(const f32x4*)(md + 1024 + col);
                const f32x4 y = v[j] * rstd * g * (sc + 1.0f) + sh;
                u32x2 w; w.x = cvt_pk_bf16(y[0], y[1]); w.y = cvt_pk_bf16(y[2], y[3]); *(u32x2*)(HX + (size_t)m * DM + col) = w; }
        }
    }
    SEAM(1);

    if (IN(2)) {
        pg8::GridOrder S{64, 9, G, bx, 8, 2, DM, (const char*)(A.ws + WS_WIN)};
        pg8::EpiIn E{WSP(bf16_t, WS_Q), WSP(bf16_t, WS_KB), WSP(bf16_t, WS_VB), WSP(bf16_t, WS_GB), WSP(bf16_t, WS_WB), A.q_g, A.k_g, WSP(float, WS_ROPE), WSP(float, WS_ROPE) + 1024};
        pg8::gemm_phase<pg8::EpiIn, pg8::GridOrder, true>(lds, (const char*)(A.ws + WS_HX), DM, S, E);
    }
    SEAM(2);

    if (IN(3)) {
        PHASE_IDS();
        const bf16_t* WBUF = WSP(bf16_t, WS_WB); const bf16_t* GBUF = WSP(bf16_t, WS_GB); bf16_t* MIX = WSP(bf16_t, WS_MIX);
        {
            const int c0 = 8 * lane;
            f32x4 t0a = *(const f32x4*)(A.conv_w + c0), t0b = *(const f32x4*)(A.conv_w + c0 + 4), t1a = *(const f32x4*)(A.conv_w + 512 + c0), t1b = *(const f32x4*)(A.conv_w + 512 + c0 + 4),
                  t2a = *(const f32x4*)(A.conv_w + 1024 + c0), t2b = *(const f32x4*)(A.conv_w + 1024 + c0 + 4);
            const f32x4 cga = *(const f32x4*)(A.conv_g + c0), cgb = *(const f32x4*)(A.conv_g + c0 + 4);
            for (int m = gw; m < NTOK; m += NGW) {
                const int t = m & (SEQ - 1);
                const u32x4 z = (u32x4){0u, 0u, 0u, 0u};
                const u32x4 vm = (t > 0) ? *(const u32x4*)(WBUF + (size_t)(m - 1) * CW + c0) : z;
                const u32x4 v0 = *(const u32x4*)(WBUF + (size_t)m * CW + c0);
                const u32x4 vp = (t < SEQ - 1) ? *(const u32x4*)(WBUF + (size_t)(m + 1) * CW + c0) : z;
                const u32x4 gb = *(const u32x4*)(GBUF + (size_t)m * CW + c0);
                float y[8];
#define CONV2(k, W_, TA, TB, TC, q) y[2 * (k)] = bf_lo(gb.W_) * (TA[q] * bf_lo(vm.W_) + TB[q] * bf_lo(v0.W_) + TC[q] * bf_lo(vp.W_)); \
                                    y[2 * (k) + 1] = bf_hi(gb.W_) * (TA[q + 1] * bf_hi(vm.W_) + TB[q + 1] * bf_hi(v0.W_) + TC[q + 1] * bf_hi(vp.W_));
                CONV2(0, x, t0a, t1a, t2a, 0) CONV2(1, y, t0a, t1a, t2a, 2) CONV2(2, z, t0b, t1b, t2b, 0) CONV2(3, w, t0b, t1b, t2b, 2)
#undef CONV2
                float ss = 0.f;
#pragma unroll
                for (int j = 0; j < 8; ++j) ss += y[j] * y[j];
                ss += __shfl_xor(ss, 1); ss += __shfl_xor(ss, 2); ss += __shfl_xor(ss, 4);
                const float rstd = 1.0f / sqrtf(ss * (1.0f / 64.0f) + EPS);
                u32x4 w; w.x = cvt_pk_bf16(y[0] * rstd * cga[0], y[1] * rstd * cga[1]); w.y = cvt_pk_bf16(y[2] * rstd * cga[2], y[3] * rstd * cga[3]);
                w.z = cvt_pk_bf16(y[4] * rstd * cgb[0], y[5] * rstd * cgb[1]); w.w = cvt_pk_bf16(y[6] * rstd * cgb[2], y[7] * rstd * cgb[3]);
                *(u32x4*)(MIX + (size_t)m * DM + 512 + c0) = w;
            }
        }
        asm volatile("s_waitcnt vmcnt(0)" ::: "memory"); __syncthreads();
        for (int uu = vcu; uu < 256; uu += G) {
            const int p = uu >> 4, w16 = uu & 15, b = p >> 1, kvh = p & 1;
#pragma unroll 1
            for (int j = 0; j < 2; ++j) { const int un = 2 * w16 + j, hq = un >> 3, qb = un & 7;
                attn_body::attn_unit<8>(b, kvh * 4 + hq, qb, WSP(const attn_body::bf16, WS_Q), WSP(const attn_body::bf16, WS_KB), WSP(const attn_body::bf16, WS_VB), WSP(attn_body::bf16, WS_MIX), A.attn_g, (char*)lds_raw); }
        }
    }
    SEAM(3);

    if (IN(4)) {
        pg8::GridOrder S{64, 4, G, bx, 0, 0, DM, (const char*)(A.ws + WS_WOUT)};
        pg8::EpiOut E{A.x, WSP(const float, WS_MOD), A.out};
        pg8::gemm_phase<pg8::EpiOut, pg8::GridOrder, true>(lds, (const char*)(A.ws + WS_MIX), DM, S, E);
    }
    SEAM(4);

    if (IN(5)) {
        PHASE_IDS();
        const float* MOD = WSP(float, WS_MOD); const float* XNEW = A.out; bf16_t* HX2 = WSP(bf16_t, WS_HX2); int* TOKI = WSP(int, WS_TOKI); float* TOKW = WSP(float, WS_TOKW); int* LIST = WSP(int, WS_LIST);
        unsigned* CNT = (unsigned*)(ctl + CW_CNT);
        LAS int* lcnt = (LAS int*)lds; LAS int* lbase = lcnt + 32; LAS int* sel = lbase + 32; LAS int* rnk = sel + 128;
        for (int rb = bx; rb < NTOK / 64; rb += G) {
            if (tid < 32) lcnt[tid] = 0;
            __syncthreads();
            for (int rr = 0; rr < 8; ++rr) {
                const int m = rb * 64 + wave * 8 + rr, b = m >> 11;
                const float* md = MOD + b * 6144;
                f32x4 v[4]; float s = 0.f;
#pragma unroll
                for (int j = 0; j < 4; ++j) { v[j] = *((const f32x4*)(XNEW + (size_t)m * DM) + lane + 64 * j); s += (v[j][0] * v[j][0] + v[j][1] * v[j][1]) + (v[j][2] * v[j][2] + v[j][3] * v[j][3]); }
                const float rstd = 1.0f / sqrtf(wave_sum(s) * (1.0f / DM) + EPS);
                float gl0 = 0.f, gl1 = 0.f, gl2 = 0.f, gl3 = 0.f;
#pragma unroll
                for (int j = 0; j < 4; ++j) { const int col = 4 * lane + 256 * j;
                    const f32x4 g = *(const f32x4*)(A.norm2_g + col), sh = *(const f32x4*)(md + 3072 + col), sc = *(const f32x4*)(md + 4096 + col);
                    const f32x4 y = v[j] * rstd * g * (sc + 1.0f) + sh; v[j] = y;
                    u32x2 w; w.x = cvt_pk_bf16(y[0], y[1]); w.y = cvt_pk_bf16(y[2], y[3]); *(u32x2*)(HX2 + (size_t)m * DM + col) = w;
#pragma unroll
                    for (int q = 0; q < 4; ++q) { const f32x4 wg = *(const f32x4*)(A.w_group + (size_t)(col + q) * 4); gl0 += y[q] * wg[0]; gl1 += y[q] * wg[1]; gl2 += y[q] * wg[2]; gl3 += y[q] * wg[3]; } }
                gl0 = wave_sum(gl0); gl1 = wave_sum(gl1); gl2 = wave_sum(gl2); gl3 = wave_sum(gl3);
                int gs = 0; float gm = gl0; if (gl1 > gm) { gm = gl1; gs = 1; } if (gl2 > gm) { gm = gl2; gs = 2; } if (gl3 > gm) { gm = gl3; gs = 3; }
                gs = __builtin_amdgcn_readfirstlane(gs);
                const float gw_ = 1.0f / (expf(gl0 - gm) + expf(gl1 - gm) + expf(gl2 - gm) + expf(gl3 - gm));
                float el[8];
#pragma unroll
                for (int q = 0; q < 8; ++q) el[q] = 0.f;
#pragma unroll
                for (int j = 0; j < 4; ++j)
#pragma unroll
                    for (int q = 0; q < 4; ++q) { const float* wr_ = A.w_router + (size_t)(4 * lane + 256 * j + q) * 32 + gs * 8; const f32x4 wa = *(const f32x4*)wr_, wb = *(const f32x4*)(wr_ + 4); const float y = v[j][q];
                        el[0] += y * wa[0]; el[1] += y * wa[1]; el[2] += y * wa[2]; el[3] += y * wa[3]; el[4] += y * wb[0]; el[5] += y * wb[1]; el[6] += y * wb[2]; el[7] += y * wb[3]; }
#pragma unroll
                for (int q = 0; q < 8; ++q) el[q] = wave_sum(el[q]);
                int i0 = 0; float m0 = el[0];
#pragma unroll
                for (int q = 1; q < 8; ++q) if (el[q] > m0) { m0 = el[q]; i0 = q; }
                int i1 = -1; float m1 = -3.0e38f;
#pragma unroll
                for (int q = 0; q < 8; ++q) if (q != i0 && el[q] > m1) { m1 = el[q]; i1 = q; }
                const float p1 = expf(m1 - m0), inv = 1.0f / (1.0f + p1);
                if (lane == 0) { const int a = (wave * 8 + rr) * 2; sel[a] = gs * 8 + i0; sel[a + 1] = gs * 8 + i1; *(f32x2*)(TOKW + (size_t)m * 2) = (f32x2){gw_ * inv, gw_ * p1 * inv}; }
            }
            __syncthreads();
            if (tid < 128) rnk[tid] = __hip_atomic_fetch_add(&lcnt[sel[tid]], 1, __ATOMIC_RELAXED, __HIP_MEMORY_SCOPE_WORKGROUP);
            __syncthreads();
            if (tid < 32) { const int c = lcnt[tid]; lbase[tid] = c ? (int)__hip_atomic_fetch_add(CNT + tid, (unsigned)c, RLX_AGENT) : 0; }
            __syncthreads();
            if (tid < 128) { const int e = sel[tid], pos = lbase[e] + rnk[tid], m = rb * 64 + (tid >> 1);
                TOKI[m * 4 + (tid & 1) * 2] = e; TOKI[m * 4 + (tid & 1) * 2 + 1] = pos; LIST[e * LISTCAP + pos] = m; }
            __syncthreads();
        }
    }
    SEAM(5);

#define MOE_PREFIX() \
        const int cnt_l = (lane < 32) ? (int)__hip_atomic_load(CNT + lane, RLX_AGENT) : 0; \
        const int ntl = (cnt_l + 255) >> 8; \
        int incl = ntl; \
        _Pragma("unroll") for (int o = 1; o < 32; o <<= 1) { const int t_ = __shfl_up(incl, o); if (lane >= o) incl += t_; } \
        const int excl = incl - ntl; \
        const int T = __shfl(incl, 31);
    if (IN(6)) {
        PHASE_IDS();
        unsigned* CNT = (unsigned*)(ctl + CW_CNT); const int* LIST = (const int*)(A.ws + WS_LIST);
        MOE_PREFIX()
        LAS int* tab = (LAS int*)(lds + TAB_OFF);
        pg8::MoeOrder<true, 6> S{G, vcu, T * 6, incl, DM, (const char*)(A.ws + WS_WUP), (size_t)NUP * DM * 2, tab};
#pragma unroll 1
        for (int i = 0; i < 4; ++i) { pg8::Unit u; if (!S.next(i, u)) break;
            const int mt = u.pm - __shfl(excl, u.e), ce = __shfl(cnt_l, u.e);
            if (tid < 256) { const int pos = mt * 256 + tid; tab[i * 256 + tid] = (pos < ce) ? LIST[u.e * LISTCAP + pos] : 0; } }
        __syncthreads();
        pg8::EpiUp E{(bf16_t*)(A.ws + WS_HB)};
        pg8::gemm_phase<pg8::EpiUp, pg8::MoeOrder<true, 6>, true>(lds, (const char*)(A.ws + WS_HX2), DM, S, E);
    }
    SEAM(6);
    if (IN(7)) {
        PHASE_IDS();
        unsigned* CNT = (unsigned*)(ctl + CW_CNT);
        MOE_PREFIX()
        (void)excl;
        pg8::MoeOrder<false, 4> S{G, vcu, T * 4, incl, DE, (const char*)(A.ws + WS_WDN), (size_t)DM * DE * 2, (const LAS int*)(lds + TAB_OFF)};
        pg8::EpiDown E{(bf16_t*)(A.ws + WS_YB)};
        pg8::gemm_phase<pg8::EpiDown, pg8::MoeOrder<false, 4>, true>(lds, (const char*)(A.ws + WS_HB), DE, S, E);
    }
    SEAM(7);

    if (IN(8)) {
        PHASE_IDS();
        const float* MOD = WSP(float, WS_MOD); const float* XNEW = A.out; const int* TOKI = WSP(int, WS_TOKI); const float* TOKW = WSP(float, WS_TOKW); const bf16_t* YB = WSP(bf16_t, WS_YB);
        unsigned* CNT = (unsigned*)(ctl + CW_CNT);
        MOE_PREFIX()
        (void)T;
        const unsigned tmo = __hip_atomic_load(ctl + CW_BAR + XB_TMO, RLX_AGENT);
        for (int m = gw; m < NTOK; m += NGW) {
            const int b = m >> 11; const float* md = MOD + b * 6144;
            const int e0 = TOKI[m * 4], p0 = TOKI[m * 4 + 1], e1 = TOKI[m * 4 + 2], p1 = TOKI[m * 4 + 3];
            const f32x2 tw = *(const f32x2*)(TOKW + (size_t)m * 2);
            const size_t r0 = (size_t)(__shfl(excl, e0 & 31) * 256 + p0), r1 = (size_t)(__shfl(excl, e1 & 31) * 256 + p1);
            f32x4 v[4]; float s = 0.f;
#pragma unroll
            for (int j = 0; j < 4; ++j) { const int col = 4 * lane + 256 * j;
                const f32x4 xs = *(const f32x4*)(XNEW + (size_t)m * DM + col), gt = *(const f32x4*)(md + 5120 + col);
                const u32x2 ya = *(const u32x2*)(YB + r0 * DM + col), yb = *(const u32x2*)(YB + r1 * DM + col);
                f32x4 y; y[0] = tw[0] * bf_lo(ya.x) + tw[1] * bf_lo(yb.x); y[1] = tw[0] * bf_hi(ya.x) + tw[1] * bf_hi(yb.x); y[2] = tw[0] * bf_lo(ya.y) + tw[1] * bf_lo(yb.y); y[3] = tw[0] * bf_hi(ya.y) + tw[1] * bf_hi(yb.y);
                v[j] = xs + gt * y; s += (v[j][0] * v[j][0] + v[j][1] * v[j][1]) + (v[j][2] * v[j][2] + v[j][3] * v[j][3]); }
            float rstd = 1.0f / sqrtf(wave_sum(s) * (1.0f / DM) + EPS);
            if (tmo) rstd = __builtin_nanf("");
#pragma unroll
            for (int j = 0; j < 4; ++j) { const int col = 4 * lane + 256 * j; const f32x4 g = *(const f32x4*)(A.final_g + col); *(f32x4*)(A.out + (size_t)m * DM + col) = v[j] * rstd * g; }
        }
    }
#undef IN
#undef SEAM
#undef MOE_PREFIX
#undef PHASE_IDS
#undef WSP
}

extern "C" void kernel_launch(void* const* d_in, const int* in_sizes, int n_in, void* d_out, int out_size, void* d_ws, size_t ws_size, hipStream_t stream) {
    static int grid = 0;
    if (grid == 0) {
        if (n_in != 21 || in_sizes[0] != NTOK * DM || out_size != NTOK * DM || ws_size < WS_END) { fprintf(stderr, "kernel_launch: unexpected shapes (n_in %d, in0 %d, out %d, ws %zu < %zu)\n", n_in, n_in > 0 ? in_sizes[0] : -1, out_size, ws_size, (size_t)WS_END); grid = -1; return; }
        int dev = 0, cus = 0, per_cu = 0;
        if (hipGetDevice(&dev) != hipSuccess || hipDeviceGetAttribute(&cus, hipDeviceAttributeMultiprocessorCount, dev) != hipSuccess) { grid = -1; return; }
        if (hipFuncSetAttribute((const void*)mk_fwd, hipFuncAttributeMaxDynamicSharedMemorySize, LDS_BYTES) != hipSuccess) { fprintf(stderr, "kernel_launch: hipFuncSetAttribute failed\n"); grid = -1; return; }
        if (hipOccupancyMaxActiveBlocksPerMultiprocessor(&per_cu, (const void*)mk_fwd, 512, LDS_BYTES) != hipSuccess || per_cu < 1) fprintf(stderr, "kernel_launch: occupancy query says %d\n", per_cu);
        (void)hipGetLastError();
        grid = cus;
    }
    if (grid < 0) return;
    (void)hipMemsetAsync((char*)d_ws + WS_CTL, 0, CTL_ZERO_BYTES, stream);
    Args a{};
    const float** p = (const float**)&a;
    for (int i = 0; i < 21; ++i) p[i] = (const float*)d_in[i];
    a.out = (float*)d_out; a.ws = (unsigned char*)d_ws;
    if (MK_N_LAUNCHES == 1) { a.ph_lo = 0; a.ph_hi = N_PHASES; hipLaunchKernelGGL(mk_fwd, dim3(grid), dim3(512), LDS_BYTES, stream, a); }
    else { for (int ph = 0; ph < N_PHASES; ++ph) { a.ph_lo = ph; a.ph_hi = ph + 1; hipLaunchKernelGGL(mk_fwd, dim3(grid), dim3(512), LDS_BYTES, stream, a); } }
}
```

```cpp
#include <hip/hip_runtime.h>
#include <hip/hip_bf16.h>
#include <cstdio>
#include <cstdint>

#ifndef MK_N_LAUNCHES
#define MK_N_LAUNCHES 1
#endif
constexpr int N_PHASES = 9;
#ifndef PROBE_REPEAT
#define PROBE_REPEAT -1
#endif
#define REP(k) for (int rep_ = 0; rep_ < ((PROBE_REPEAT == (k)) ? 2 : 1); ++rep_)

constexpr int DM = 1024, NB = 8, SEQ = 2048, NTOK = NB * SEQ, CTXL = 256, NCTX = NB * CTXL, MROWS = NTOK + NCTX;
constexpr int NCOLS = 2304, AW = 512, HD = 64, KVW = 128, CW = 512, SKV = CTXL + SEQ;
constexpr int NE = 32, EPG = 8, DE = 768, NUP = 2 * DE, LISTCAP = NTOK;
constexpr int PROWS = 2 * NTOK + NE * 256;
constexpr float EPS = 1e-6f;
constexpr float C2 = 0.125f * 1.4426950408889634f;

constexpr size_t MiB = 1u << 20;
constexpr size_t WS_CTL = 0, CTL_ZERO_BYTES = 1 * MiB;
constexpr size_t WS_MOD = 1 * MiB;
constexpr size_t WS_ROPE = WS_MOD + 256 * 1024;
constexpr size_t WS_WRT = WS_ROPE + 64 * 1024;
constexpr size_t WS_TOKI = 2 * MiB;
constexpr size_t WS_TOKW = WS_TOKI + 256 * 1024;
constexpr size_t WS_LIST = 3 * MiB;
constexpr size_t WS_WIN = 5 * MiB;
constexpr size_t WS_WOUT = 10 * MiB;
constexpr size_t WS_WUP = 12 * MiB;
constexpr size_t WS_WDN = 108 * MiB;
constexpr size_t WS_HX2 = 156 * MiB;
constexpr size_t WS_R1 = 188 * MiB;
constexpr size_t WS_HX = WS_R1;
constexpr size_t WS_Q = WS_R1 + 36 * MiB;
constexpr size_t WS_KB = WS_R1 + 52 * MiB;
constexpr size_t WS_VB = WS_R1 + 57 * MiB;
constexpr size_t WS_GB = WS_R1 + 62 * MiB;
constexpr size_t WS_WB = WS_R1 + 78 * MiB;
constexpr size_t WS_MIX = WS_R1 + 94 * MiB;
constexpr size_t WS_HB = WS_R1;
constexpr size_t WS_YB = WS_R1 + 60 * MiB;
constexpr size_t WS_END = WS_R1 + 140 * MiB;
constexpr int CW_TMO = 0;
constexpr int CW_CNT = 64;
constexpr int CW_BAR = 4096;

constexpr int RING_BYTES = 131072;
constexpr int TAB_OFF = RING_BYTES;
constexpr int WRT_BYTES = 36 * 1024 * 4;
constexpr int P5S_OFF = WRT_BYTES;
constexpr int LDS_BYTES = 163840;
constexpr int MISC_OFF = LDS_BYTES - 512;

#define GAS __attribute__((address_space(1)))
#define LAS __attribute__((address_space(3)))
typedef unsigned short bf16_t;
typedef unsigned u32x4 __attribute__((ext_vector_type(4)));
typedef unsigned u32x2 __attribute__((ext_vector_type(2)));
typedef float f32x4 __attribute__((ext_vector_type(4)));
typedef float f32x2 __attribute__((ext_vector_type(2)));
typedef short bf16x8 __attribute__((ext_vector_type(8)));
typedef GAS unsigned gu32;
#define RLX_AGENT __ATOMIC_RELAXED, __HIP_MEMORY_SCOPE_AGENT

__device__ __forceinline__ unsigned cvt_pk_bf16(float lo, float hi) { unsigned r; asm volatile("v_cvt_pk_bf16_f32 %0, %1, %2" : "=v"(r) : "v"(lo), "v"(hi)); return r; }
__device__ __forceinline__ float bf_lo(unsigned w) { return __uint_as_float(w << 16); }
__device__ __forceinline__ float bf_hi(unsigned w) { return __uint_as_float(w & 0xffff0000u); }
__device__ __forceinline__ float wave_sum(float v) {
#pragma unroll
    for (int o = 1; o < 64; o <<= 1) v += __shfl_xor(v, o);
    return v;
}
__device__ __forceinline__ float dpp_term(float v, const int ctrl_sel) {
    const int x = __builtin_bit_cast(int, v); int r;
    if (ctrl_sel == 0) r = __builtin_amdgcn_update_dpp(0, x, 0xB1, 0xf, 0xf, false);
    else if (ctrl_sel == 1) r = __builtin_amdgcn_update_dpp(0, x, 0x4E, 0xf, 0xf, false);
    else if (ctrl_sel == 2) r = __builtin_amdgcn_update_dpp(0, x, 0x141, 0xf, 0xf, false);
    else if (ctrl_sel == 3) r = __builtin_amdgcn_update_dpp(0, x, 0x140, 0xf, 0xf, false);
    else if (ctrl_sel == 4) r = __builtin_amdgcn_update_dpp(0, x, 0x142, 0xa, 0xf, false);
    else r = __builtin_amdgcn_update_dpp(0, x, 0x143, 0xc, 0xf, false);
    return __builtin_bit_cast(float, r);
}
__device__ __forceinline__ float wave_sum_u(float v) {
    v += dpp_term(v, 0); v += dpp_term(v, 1); v += dpp_term(v, 2); v += dpp_term(v, 3); v += dpp_term(v, 4); v += dpp_term(v, 5);
    return __builtin_bit_cast(float, __builtin_amdgcn_readlane(__builtin_bit_cast(int, v), 63));
}
__host__ __device__ __forceinline__ int invperm32(int l) { return 16 * ((l >> 2) & 1) + 4 * (l >> 3) + (l & 3); }

__host__ __device__ __forceinline__ int drow_win(int n) {
    if (n < 512) { const int h = n >> 6, d = n & 63; return 256 * (h >> 2) + 128 * (d >> 5) + 32 * (h & 3) + (d & 31); }
    if (n < 768) { const int hh = (n - 512) >> 6, d = n & 63; return 512 + 128 * (d >> 5) + 32 * hh + (d & 31); }
    if (n < 1280) { const int c = n - 768; return 768 + (c & ~31) + invperm32(c & 31); }
    if (n < 1792) { const int c = n - 1280; return 1280 + 256 * (c >> 7) + ((c & 127) & ~31) + invperm32(c & 31); }
    { const int c = n - 1792; return 1280 + 256 * (c >> 7) + 128 + ((c & 127) & ~31) + invperm32(c & 31); }
}
__host__ __device__ __forceinline__ int drow_gu(int n, int up) { return 256 * (n >> 7) + 128 * up + ((n & 127) & ~31) + invperm32(n & 31); }
__host__ __device__ __forceinline__ int drow_dn(int n) { return (n & ~31) + invperm32(n & 31); }

namespace pg8 {
constexpr int BM = 256, BK = 64, HALF = 128, HTB = HALF * BK * 2, STAGE_BYTES = 8 * HTB;
__host__ __device__ __forceinline__ int lds_byte(int r, int c) { const int st = (r >> 4) * 2 + (c >> 5), rr = r & 15, cc = c & 31, ob = rr * 64 + cc * 2; return st * 1024 + (ob ^ (((ob >> 9) & 1) << 5)); }
__host__ __device__ __forceinline__ void stage_rc(int b, int& R, int& C) { const int st = b / 1024, sb = b % 1024, swz = sb ^ (((sb >> 9) & 1) << 5); R = (st >> 1) * 16 + swz / 64; C = (st & 1) * 32 + (swz % 64) / 2; }

struct Unit { int pm, pn, ui, e; };

template <class Epi, class Sched, bool ALIGN_EPI>
__device__ __forceinline__ void gemm_phase(LAS unsigned char* lds, const char* Abase, const int K, const Sched& S, const Epi& E) {
    const int tid = threadIdx.x, wid = __builtin_amdgcn_readfirstlane(tid >> 6), lane = tid & 63, wr = wid >> 2, wc = wid & 3, fr = lane & 15, fq = lane >> 4;
    const int nt = K / BK;
    int Rr[2], Cb[2]; unsigned voffB[2];
#pragma unroll
    for (int i = 0; i < 2; ++i) { int R, C; stage_rc(tid * 16 + i * 8192, R, C); Rr[i] = R; Cb[i] = C * 2; voffB[i] = (unsigned)(R * K + C) * 2u; }
    const size_t kstep = (size_t)(BK * 2);
    const size_t hstep = (size_t)HALF * K * 2;
    const unsigned ldsw = (unsigned)wid * 1024u;
    const int aoff = lds_byte(wr * 64 + fr, fq * 8), boff = lds_byte(wc * 32 + fr, fq * 8);
#define PG8_SA(b, h) (((b) * 2 + (h)) * HTB)
#define PG8_SB(b, h) ((4 + (b) * 2 + (h)) * HTB)
#define PG8_STAGEB(bufoff, gbase) do { _Pragma("unroll") for (int _i = 0; _i < 2; ++_i) \
        __builtin_amdgcn_global_load_lds((const unsigned*)((const char*)(gbase) + voffB[_i]), (LAS unsigned*)(lds + (bufoff) + ldsw + _i * 8192), 16, 0, 0); } while (0)
#define PG8_STAGEA(bufoff, o0, o1, kb) do { \
        __builtin_amdgcn_global_load_lds((const unsigned*)(Abase + (size_t)(o0) + (size_t)(kb)), (LAS unsigned*)(lds + (bufoff) + ldsw), 16, 0, 0); \
        __builtin_amdgcn_global_load_lds((const unsigned*)(Abase + (size_t)(o1) + (size_t)(kb)), (LAS unsigned*)(lds + (bufoff) + ldsw + 8192), 16, 0, 0); } while (0)
#define PG8_LDA(dst, b, h) do { _Pragma("unroll") for (int m = 0; m < 4; ++m) _Pragma("unroll") for (int k = 0; k < 2; ++k) dst[m][k] = *(const LAS bf16x8*)(lds + PG8_SA(b, h) + aoff + m * 2048 + k * 1024); } while (0)
#define PG8_LDB(dst, b, h) do { _Pragma("unroll") for (int n = 0; n < 2; ++n) _Pragma("unroll") for (int k = 0; k < 2; ++k) dst[n][k] = *(const LAS bf16x8*)(lds + PG8_SB(b, h) + boff + n * 2048 + k * 1024); } while (0)
#define PG8_MMA(ai, bj, At, Bt) do { __builtin_amdgcn_s_setprio(1); _Pragma("unroll") for (int m = 0; m < 4; ++m) _Pragma("unroll") for (int n = 0; n < 2; ++n) _Pragma("unroll") for (int k = 0; k < 2; ++k) \
        acc[ai][bj][m][n] = __builtin_amdgcn_mfma_f32_16x16x32_bf16(Bt[n][k], At[m][k], acc[ai][bj][m][n], 0, 0, 0); __builtin_amdgcn_s_setprio(0); } while (0)
#define PG8_WAIT_V(n) asm volatile("s_waitcnt vmcnt(" #n ")" ::: "memory")
#define PG8_WAIT_L(n) asm volatile("s_waitcnt lgkmcnt(" #n ")" ::: "memory")
#define PG8_BAR __builtin_amdgcn_s_barrier()
#define PG8_SCHED __builtin_amdgcn_sched_barrier(0)
    Unit cur, nxt; int ui = 0;
    if (!S.next(0, cur)) return;
    f32x4 acc[2][2][4][2];
#pragma unroll
    for (int a = 0; a < 2; ++a)
#pragma unroll
        for (int b = 0; b < 2; ++b)
#pragma unroll
            for (int m = 0; m < 4; ++m)
#pragma unroll
                for (int n = 0; n < 2; ++n) acc[a][b][m][n] = (f32x4){0.f, 0.f, 0.f, 0.f};
    bf16x8 At[4][2], B0[2][2], B1[2][2];
    unsigned ao[2][2], an[2][2];
    S.a_off(cur, Rr, Cb, ao);
    const char* cB = S.b_ptr(cur);
    PG8_STAGEB(PG8_SB(0, 0), cB); PG8_STAGEB(PG8_SB(0, 1), cB + hstep); PG8_STAGEA(PG8_SA(0, 0), ao[0][0], ao[0][1], 0); PG8_STAGEA(PG8_SA(0, 1), ao[1][0], ao[1][1], 0);
    if (wr == 1) PG8_BAR;
    PG8_WAIT_V(2); PG8_BAR;
    PG8_STAGEB(PG8_SB(1, 0), cB + kstep); PG8_STAGEA(PG8_SA(1, 0), ao[0][0], ao[0][1], kstep); PG8_STAGEB(PG8_SB(1, 1), cB + hstep + kstep);
    PG8_WAIT_V(6); PG8_BAR;
    for (;;) {
        const bool has_next = S.next(ui + 1, nxt);
        const char* nB = cB;
        if (has_next) { S.a_off(nxt, Rr, Cb, an); nB = S.b_ptr(nxt); }
        else {
#pragma unroll
            for (int h = 0; h < 2; ++h)
#pragma unroll
                for (int i = 0; i < 2; ++i) an[h][i] = ao[h][i];
        }
        for (int t = 0; t < nt; t += 2) {
            const bool last = (t == nt - 2);
            const size_t k1 = (size_t)(t + 1) * kstep;
            const size_t k2 = last ? 0 : (size_t)(t + 2) * kstep, k3 = k2 + kstep;
            const unsigned s00 = last ? an[0][0] : ao[0][0], s01 = last ? an[0][1] : ao[0][1], s10 = last ? an[1][0] : ao[1][0], s11 = last ? an[1][1] : ao[1][1];
            const char* b2 = last ? nB : cB + (size_t)(t + 2) * kstep; const char* b3 = b2 + kstep;
            PG8_LDB(B0, 0, 0); PG8_LDB(B1, 0, 1); PG8_SCHED; PG8_LDA(At, 0, 0); PG8_STAGEA(PG8_SA(1, 1), ao[1][0], ao[1][1], k1);
            PG8_WAIT_V(8); PG8_WAIT_L(0); PG8_BAR; PG8_MMA(0, 0, At, B0); PG8_MMA(0, 1, At, B1); PG8_BAR; PG8_SCHED;
            PG8_LDA(At, 0, 1); PG8_STAGEB(PG8_SB(0, 0), b2); PG8_STAGEB(PG8_SB(0, 1), b2 + hstep); PG8_STAGEA(PG8_SA(0, 0), s00, s01, k2);
            PG8_WAIT_V(8); PG8_WAIT_L(0); PG8_BAR; PG8_MMA(1, 0, At, B0); PG8_MMA(1, 1, At, B1); PG8_BAR; PG8_SCHED;
            PG8_LDB(B0, 1, 0); PG8_LDB(B1, 1, 1); PG8_SCHED; PG8_LDA(At, 1, 0); PG8_STAGEA(PG8_SA(0, 1), s10, s11, k2);
            PG8_WAIT_V(8); PG8_WAIT_L(0); PG8_BAR; PG8_MMA(0, 0, At, B0); PG8_MMA(0, 1, At, B1); PG8_BAR; PG8_SCHED;
            PG8_LDA(At, 1, 1); PG8_STAGEB(PG8_SB(1, 0), b3); PG8_STAGEB(PG8_SB(1, 1), b3 + hstep); PG8_STAGEA(PG8_SA(1, 0), s00, s01, k3);
            PG8_WAIT_V(8); PG8_WAIT_L(0); PG8_BAR; PG8_MMA(1, 0, At, B0); PG8_MMA(1, 1, At, B1); PG8_BAR; PG8_SCHED;
        }
        if constexpr (ALIGN_EPI) { if (wr == 0) PG8_BAR; }
        E(acc, cur, wr, wc, fr, fq);
        if (!has_next) break;
#pragma unroll
        for (int a = 0; a < 2; ++a)
#pragma unroll
            for (int b = 0; b < 2; ++b)
#pragma unroll
                for (int m = 0; m < 4; ++m)
#pragma unroll
                    for (int n = 0; n < 2; ++n) acc[a][b][m][n] = (f32x4){0.f, 0.f, 0.f, 0.f};
        cur = nxt; cB = nB; ++ui;
#pragma unroll
        for (int h = 0; h < 2; ++h)
#pragma unroll
            for (int i = 0; i < 2; ++i) ao[h][i] = an[h][i];
        if constexpr (ALIGN_EPI) { if (wr == 1) PG8_BAR; }
    }
    PG8_WAIT_V(0);
    if constexpr (!ALIGN_EPI) { if (wr == 0) PG8_BAR; }
    PG8_BAR;
#undef PG8_SA
#undef PG8_SB
#undef PG8_STAGEA
#undef PG8_STAGEB
#undef PG8_LDA
#undef PG8_LDB
#undef PG8_MMA
#undef PG8_WAIT_V
#undef PG8_WAIT_L
#undef PG8_BAR
#undef PG8_SCHED
}

__device__ __forceinline__ void dense_off(int pm, int K, const int (&R)[2], const int (&Cb)[2], unsigned (&off)[2][2]) {
#pragma unroll
    for (int h = 0; h < 2; ++h)
#pragma unroll
        for (int i = 0; i < 2; ++i) off[h][i] = (unsigned)((pm * 256 + h * 128 + R[i]) * K) * 2u + (unsigned)Cb[i];
}
struct GridOrder {
    int nM, nN, G, c, nExtra, extra_pn, K; const char* Bt;
    __device__ __forceinline__ bool next(int i, Unit& u) const {
        const int L = i * G + c, nwg = nM * nN; u.ui = i; u.e = 0;
        if (L >= nwg) { if (L - nwg < nExtra) { u.pm = nM + (L - nwg); u.pn = extra_pn; return true; } return false; }
        int wgid = L; { const int q = nwg / 8, r = nwg % 8, xcd = wgid % 8, off = wgid / 8; wgid = (xcd < r ? xcd * (q + 1) : r * (q + 1) + (xcd - r) * q) + off; }
        const int nig = 8 * nN, gid = wgid / nig, fm = gid * 8, gsz = (nM - fm) < 8 ? (nM - fm) : 8;
        u.pm = fm + ((wgid % nig) % gsz); u.pn = (wgid % nig) / gsz; return true;
    }
    __device__ __forceinline__ void a_off(const Unit& u, const int (&R)[2], const int (&Cb)[2], unsigned (&off)[2][2]) const { dense_off(u.pm, K, R, Cb, off); }
    __device__ __forceinline__ const char* b_ptr(const Unit& u) const { return Bt + (size_t)u.pn * 256 * K * 2; }
};
template <bool GATHER, int NN>
struct MoeOrder {
    int G, vcu, U, incl; int K; const char* Bt; size_t estride; const LAS int* tab;
    __device__ __forceinline__ bool next(int i, Unit& u) const {
        const int L = i * G + vcu; if (L >= U) return false;
        u.ui = i; u.pm = L / NN; u.pn = L - u.pm * NN;
        u.e = (int)__popcll(__ballot((threadIdx.x & 63) < 32 && incl <= u.pm)) & 31; return true;
    }
    __device__ __forceinline__ void a_off(const Unit& u, const int (&R)[2], const int (&Cb)[2], unsigned (&off)[2][2]) const {
        if constexpr (GATHER) {
#pragma unroll
            for (int h = 0; h < 2; ++h)
#pragma unroll
                for (int i = 0; i < 2; ++i) { const int tok = tab[u.ui * 256 + h * 128 + R[i]]; off[h][i] = (unsigned)(tok * K) * 2u + (unsigned)Cb[i]; }
        } else dense_off(u.pm, K, R, Cb, off);
    }
    __device__ __forceinline__ const char* b_ptr(const Unit& u) const { return Bt + (size_t)u.e * estride + (size_t)u.pn * 256 * K * 2; }
};

struct EpiIn {
    bf16_t *Q, *KB, *VB, *GB, *WB; const float *qg, *kg, *cosT, *sinT;
    __device__ __forceinline__ void operator()(const f32x4 (&acc)[2][2][4][2], const Unit& u, int wr, int wc, int fr, int fq) const {
        const int pn = u.pn, pm = u.pm;
        if (pn >= 3) {
            if (pn < 5) {
#pragma unroll
                for (int ai = 0; ai < 2; ++ai)
#pragma unroll
                    for (int m = 0; m < 4; ++m) { bf16_t* rowp = GB + (size_t)(pm * 256 + ai * 128 + wr * 64 + m * 16 + fr) * CW + (pn - 3) * 256 + wc * 32 + 8 * fq;
#pragma unroll
                        for (int bj = 0; bj < 2; ++bj) { const f32x4 v0 = acc[ai][bj][m][0], v1 = acc[ai][bj][m][1]; u32x4 w; w.x = cvt_pk_bf16(v0[0], v0[1]); w.y = cvt_pk_bf16(v0[2], v0[3]); w.z = cvt_pk_bf16(v1[0], v1[1]); w.w = cvt_pk_bf16(v1[2], v1[3]);
                            *(u32x4*)(rowp + bj * 128) = w; } }
            } else {
#pragma unroll
                for (int ai = 0; ai < 2; ++ai)
#pragma unroll
                    for (int m = 0; m < 4; ++m) { bf16_t* rowp = WB + (size_t)(pm * 256 + ai * 128 + wr * 64 + m * 16 + fr) * CW + (pn - 5) * 128 + wc * 32 + 8 * fq;
                        const f32x4 v0 = acc[ai][0][m][0] * acc[ai][1][m][0], v1 = acc[ai][0][m][1] * acc[ai][1][m][1];
                        u32x4 w; w.x = cvt_pk_bf16(v0[0], v0[1]); w.y = cvt_pk_bf16(v0[2], v0[3]); w.z = cvt_pk_bf16(v1[0], v1[1]); w.w = cvt_pk_bf16(v1[2], v1[3]);
                        *(u32x4*)rowp = w; }
            }
            return;
        }
        const bool isq = pn < 2, isv = (pn == 2) && (wc >= 2), latent = pm < 64;
        f32x4 g[2][2];
#pragma unroll
        for (int bj = 0; bj < 2; ++bj)
#pragma unroll
            for (int n = 0; n < 2; ++n) g[bj][n] = isv ? (f32x4){1.f, 1.f, 1.f, 1.f} : *(const f32x4*)((isq ? qg : kg) + 32 * bj + 16 * n + 4 * fq);
#pragma unroll
        for (int ai = 0; ai < 2; ++ai)
#pragma unroll
            for (int m = 0; m < 4; ++m) {
                const int rl = ai * 128 + wr * 64 + m * 16 + fr;
                f32x4 x[2][2];
#pragma unroll
                for (int bj = 0; bj < 2; ++bj)
#pragma unroll
                    for (int n = 0; n < 2; ++n) x[bj][n] = acc[ai][bj][m][n];
                if (!isv) {
                    float ss = 0.f;
#pragma unroll
                    for (int bj = 0; bj < 2; ++bj)
#pragma unroll
                        for (int n = 0; n < 2; ++n) { const f32x4 v = x[bj][n]; ss += (v[0] * v[0] + v[1] * v[1]) + (v[2] * v[2] + v[3] * v[3]); }
                    ss += __shfl_xor(ss, 16); ss += __shfl_xor(ss, 32);
                    const float rstd = 1.0f / sqrtf(ss * (1.0f / 64.0f) + EPS);
#pragma unroll
                    for (int bj = 0; bj < 2; ++bj)
#pragma unroll
                        for (int n = 0; n < 2; ++n) x[bj][n] = x[bj][n] * rstd * g[bj][n];
                    if (latent) {
                        const int t = (pm * 256 + rl) & (SEQ - 1);
#pragma unroll
                        for (int bj = 0; bj < 2; ++bj) {
                            const int idx = bj == 0 ? (t >> 6) : (t & 63);
                            const f32x4 c = *(const f32x4*)(cosT + idx * 16 + 4 * fq), s = *(const f32x4*)(sinT + idx * 16 + 4 * fq);
                            const f32x4 x1 = x[bj][0], x2 = x[bj][1];
                            x[bj][0] = x1 * c - x2 * s; x[bj][1] = x1 * s + x2 * c;
                        }
                    }
                    if (isq) {
#pragma unroll
                        for (int bj = 0; bj < 2; ++bj)
#pragma unroll
                            for (int n = 0; n < 2; ++n) x[bj][n] = x[bj][n] * C2;
                    }
                }
                bf16_t* dst;
                if (isq) dst = Q + (size_t)(pm * 256 + rl) * AW + (4 * pn + wc) * 64;
                else {
                    const int b = latent ? (pm >> 3) : (pm - 64);
                    const int pos = latent ? (CTXL + ((pm * 256 + rl) & (SEQ - 1))) : rl;
                    dst = (isv ? VB : KB) + (size_t)(b * SKV + pos) * KVW + (wc & 1) * 64;
                }
#pragma unroll
                for (int bj = 0; bj < 2; ++bj)
#pragma unroll
                    for (int n = 0; n < 2; ++n) { const f32x4 v = x[bj][n]; u32x2 w; w.x = cvt_pk_bf16(v[0], v[1]); w.y = cvt_pk_bf16(v[2], v[3]); *(u32x2*)(dst + 32 * bj + 16 * n + 4 * fq) = w; }
            }
    }
};
struct EpiOut {
    const float* x; const float* mod; float* xnew;
    __device__ __forceinline__ void operator()(const f32x4 (&acc)[2][2][4][2], const Unit& u, int wr, int wc, int fr, int fq) const {
        const int b = u.pm >> 3;
#pragma unroll
        for (int bj = 0; bj < 2; ++bj)
#pragma unroll
            for (int n = 0; n < 2; ++n) {
                const int col = u.pn * 256 + bj * 128 + wc * 32 + n * 16 + 4 * fq;
                const f32x4 gt = *(const f32x4*)(mod + b * 6144 + 2048 + col);
#pragma unroll
                for (int ai = 0; ai < 2; ++ai)
#pragma unroll
                    for (int m = 0; m < 4; ++m) { const size_t off = (size_t)(u.pm * 256 + ai * 128 + wr * 64 + m * 16 + fr) * DM + col;
                        const f32x4 xs = *(const f32x4*)(x + off); *(f32x4*)(xnew + off) = xs + gt * acc[ai][bj][m][n]; }
            }
    }
};
__device__ __forceinline__ float silu_f(float g) { return g * __builtin_amdgcn_rcpf(1.0f + __builtin_amdgcn_exp2f(-1.4426950408889634f * g)); }
struct EpiUp {
    bf16_t* H;
    __device__ __forceinline__ void operator()(const f32x4 (&acc)[2][2][4][2], const Unit& u, int wr, int wc, int fr, int fq) const {
#pragma unroll
        for (int ai = 0; ai < 2; ++ai)
#pragma unroll
            for (int m = 0; m < 4; ++m) { bf16_t* rowp = H + (size_t)(u.pm * 256 + ai * 128 + wr * 64 + m * 16 + fr) * DE + u.pn * 128 + wc * 32 + 8 * fq;
                f32x4 h0, h1;
#pragma unroll
                for (int j = 0; j < 4; ++j) { h0[j] = silu_f(acc[ai][0][m][0][j]) * acc[ai][1][m][0][j]; h1[j] = silu_f(acc[ai][0][m][1][j]) * acc[ai][1][m][1][j]; }
                u32x4 w; w.x = cvt_pk_bf16(h0[0], h0[1]); w.y = cvt_pk_bf16(h0[2], h0[3]); w.z = cvt_pk_bf16(h1[0], h1[1]); w.w = cvt_pk_bf16(h1[2], h1[3]);
                *(u32x4*)rowp = w; }
    }
};
struct EpiDown {
    bf16_t* Y;
    __device__ __forceinline__ void operator()(const f32x4 (&acc)[2][2][4][2], const Unit& u, int wr, int wc, int fr, int fq) const {
#pragma unroll
        for (int ai = 0; ai < 2; ++ai)
#pragma unroll
            for (int m = 0; m < 4; ++m) { bf16_t* rowp = Y + (size_t)(u.pm * 256 + ai * 128 + wr * 64 + m * 16 + fr) * DM + u.pn * 256 + wc * 32 + 8 * fq;
#pragma unroll
                for (int bj = 0; bj < 2; ++bj) { const f32x4 v0 = acc[ai][bj][m][0], v1 = acc[ai][bj][m][1]; u32x4 w; w.x = cvt_pk_bf16(v0[0], v0[1]); w.y = cvt_pk_bf16(v0[2], v0[3]); w.z = cvt_pk_bf16(v1[0], v1[1]); w.w = cvt_pk_bf16(v1[2], v1[3]);
                    *(u32x4*)(rowp + bj * 128) = w; } }
    }
};
}

namespace attn_body {
using bf16 = __hip_bfloat16;
using bf16x8 = __attribute__((ext_vector_type(8))) short;
using s16x4 = __attribute__((ext_vector_type(4))) short;
using f32x16 = __attribute__((ext_vector_type(16))) float;
using u32x4 = __attribute__((ext_vector_type(4))) unsigned;
constexpr int D = 64, QP = AW  , KP = KVW  , OP = DM  ;
constexpr int NW = 8, QBLK = 32, QB = QBLK * NW, KVBLK = 64;
__device__ __forceinline__ int crow(int r, int hi) { return (r & 3) + 8 * (r >> 2) + 4 * hi; }
#define SBAR() __builtin_amdgcn_sched_barrier(0)
constexpr int NSLOT = 3, SLOTB = 8192;
constexpr int LDS_K = 0, LDS_V = NSLOT * SLOTB, LDS_WS = 2 * NSLOT * SLOTB, LDS_OST = LDS_WS + NW * 64 * 4, LDS_BYTES_A = LDS_OST + NW * 4096;
__device__ __forceinline__ void glds16(const void* gsrc, unsigned lds_dst) { unsigned keep;
  asm volatile("s_mov_b32 %0, m0\n\ts_mov_b32 m0, %2\n\ts_nop 0\n\tglobal_load_lds_dwordx4 %1, off\n\ts_mov_b32 m0, %0" : "=&s"(keep) : "v"(gsrc), "s"(lds_dst) : "memory"); }
__device__ __forceinline__ float max3f(float a, float b, float c) { float r; asm("v_max3_f32 %0, %1, %2, %3" : "=v"(r) : "v"(a), "v"(b), "v"(c)); return r; }
__device__ __forceinline__ float max2f(float a, float b) { float r; asm("v_max_f32_e32 %0, %1, %2" : "=v"(r) : "v"(a), "v"(b)); return r; }
__device__ __forceinline__ float fadd_s(float a, float b) { float r; asm("v_add_f32_e32 %0, %1, %2" : "=v"(r) : "v"(a), "v"(b)); return r; }
__device__ __forceinline__ float fsub_s(float a, float b) { float r; asm("v_sub_f32_e32 %0, %1, %2" : "=v"(r) : "v"(a), "v"(b)); return r; }
typedef float f32x2_t __attribute__((ext_vector_type(2))); typedef __bf16 bf16x2_t __attribute__((ext_vector_type(2)));
__device__ __forceinline__ unsigned cvtpk_s(float lo, float hi) { f32x2_t v = {lo, hi}; bf16x2_t b = __builtin_convertvector(v, bf16x2_t); return __builtin_bit_cast(unsigned, b); }
#define WAIT_BAR(N) asm volatile("s_waitcnt vmcnt(" #N ") lgkmcnt(0)\n\ts_barrier" ::: "memory")

__device__ __forceinline__ void qkt(f32x16& p0, f32x16& p1, const char* Kslot, const bf16x8* qr, const f32x16& negm, int r32, int hi) {
  const char* kb = Kslot + hi * 1024 + r32 * 16;
  #pragma unroll
  for (int d0 = 0; d0 < 4; ++d0) {
    const bf16x8 b0 = *reinterpret_cast<const bf16x8*>(kb + d0 * 2048);
    const bf16x8 b1 = *reinterpret_cast<const bf16x8*>(kb + d0 * 2048 + 512);
    if (d0 == 0) { p0 = __builtin_amdgcn_mfma_f32_32x32x16_bf16(b0, qr[0], negm, 0, 0, 0); p1 = __builtin_amdgcn_mfma_f32_32x32x16_bf16(b1, qr[0], negm, 0, 0, 0); }
    else { p0 = __builtin_amdgcn_mfma_f32_32x32x16_bf16(b0, qr[d0], p0, 0, 0, 0); p1 = __builtin_amdgcn_mfma_f32_32x32x16_bf16(b1, qr[d0], p1, 0, 0, 0); } }
}
typedef __attribute__((address_space(3))) const char* lds_cptr;
typedef short v4i16_t __attribute__((ext_vector_type(4)));
__device__ __forceinline__ void kload8(bf16x8* kf, lds_cptr kp) {
  kf[0] = *(const __attribute__((address_space(3))) bf16x8*)(kp);        kf[1] = *(const __attribute__((address_space(3))) bf16x8*)(kp + 512);
  kf[2] = *(const __attribute__((address_space(3))) bf16x8*)(kp + 2048); kf[3] = *(const __attribute__((address_space(3))) bf16x8*)(kp + 2560);
  kf[4] = *(const __attribute__((address_space(3))) bf16x8*)(kp + 4096); kf[5] = *(const __attribute__((address_space(3))) bf16x8*)(kp + 4608);
  kf[6] = *(const __attribute__((address_space(3))) bf16x8*)(kp + 6144); kf[7] = *(const __attribute__((address_space(3))) bf16x8*)(kp + 6656);
}
__device__ __forceinline__ void kload2(bf16x8* kf, lds_cptr kp, int j) { kf[2 * j] = *(const __attribute__((address_space(3))) bf16x8*)(kp + j * 2048); kf[2 * j + 1] = *(const __attribute__((address_space(3))) bf16x8*)(kp + j * 2048 + 512); }
__device__ __forceinline__ s16x4 vtr(lds_cptr p) { return __builtin_bit_cast(s16x4, __builtin_amdgcn_ds_read_tr16_b64_v4i16((__attribute__((address_space(3))) v4i16_t*)p)); }
__device__ __forceinline__ float rowmax(const f32x16& p0, const f32x16& p1) {
  float a = max3f(p0[0], p0[1], p1[0]), b = max3f(p0[2], p0[3], p1[1]); a = max3f(a, p1[2], p1[3]);
  #pragma unroll
  for (int r = 4; r < 16; r += 4) { a = max3f(a, p0[r], p0[r + 1]); b = max3f(b, p0[r + 2], p0[r + 3]); a = max3f(a, p1[r], p1[r + 1]); b = max3f(b, p1[r + 2], p1[r + 3]); }
  const float m = max2f(a, b);
  auto rr = __builtin_amdgcn_permlane32_swap(__float_as_uint(m), __float_as_uint(m), false, false);
  return max2f(__uint_as_float(rr[0]), __uint_as_float(rr[1]));
}
__device__ __forceinline__ void pv(f32x16* o, int vb, bf16x8 pa0, bf16x8 pa1, bf16x8 pa2, bf16x8 pa3) {
  #pragma unroll
  for (int d0 = 0; d0 < 2; ++d0) { s16x4 lo[4], hi[4];
    #pragma unroll
    for (int ks = 0; ks < 4; ++ks) {
      asm volatile("ds_read_b64_tr_b16 %0,%1 offset:%c2" : "=&v"(lo[ks]) : "v"(vb), "i"(d0 * 4096 + ks * 1024) : "memory");
      asm volatile("ds_read_b64_tr_b16 %0,%1 offset:%c2" : "=&v"(hi[ks]) : "v"(vb), "i"(d0 * 4096 + ks * 1024 + 512) : "memory"); }
    asm volatile("s_waitcnt lgkmcnt(0)" ::: "memory"); SBAR();
    #define PK(k) (bf16x8){lo[k][0], lo[k][1], lo[k][2], lo[k][3], hi[k][0], hi[k][1], hi[k][2], hi[k][3]}
    o[d0] = __builtin_amdgcn_mfma_f32_32x32x16_bf16(pa0, PK(0), o[d0], 0, 0, 0);
    o[d0] = __builtin_amdgcn_mfma_f32_32x32x16_bf16(pa1, PK(1), o[d0], 0, 0, 0);
    o[d0] = __builtin_amdgcn_mfma_f32_32x32x16_bf16(pa2, PK(2), o[d0], 0, 0, 0);
    o[d0] = __builtin_amdgcn_mfma_f32_32x32x16_bf16(pa3, PK(3), o[d0], 0, 0, 0);
    #undef PK
  }
}

template <int THRL> __device__ __forceinline__ void attn_unit(int b, int h, int qb, const bf16* Q, const bf16* __restrict__ K, const bf16* __restrict__ V, bf16* O, const float* og, char* shm) {
  int tid = threadIdx.x; asm volatile("" : "+v"(tid));
  const int lane = tid & 63, r32 = lane & 31, hi = lane >> 5; const int wid = __builtin_amdgcn_readfirstlane(tid >> 6);
  const int q0 = qb * QB; const int kvh = h >> 2;
  const bf16* Qw = Q + ((long)b * SEQ + q0 + wid * QBLK) * QP + h * D;
  const bf16 *Kh = K + (long)b * SKV * KP + kvh * D, *Vh = V + (long)b * SKV * KP + kvh * D;
  const unsigned lds0 = (unsigned)(uintptr_t)shm;
  float* wsf = (float*)(shm + LDS_WS) + wid * 64;
  const bf16* ksrc = Kh + (long)lane * KP + wid * 8;
  const bf16* vsrc = Vh + (long)(16 * (wid & 3) + (lane >> 2)) * KP + (wid >> 2) * 32 + (lane & 3) * 8;
  const unsigned kdst = lds0 + LDS_K + wid * 1024, vdst = lds0 + LDS_V + wid * 1024;
  #define DMA_K(t, slot) glds16(ksrc + (long)(t) * KVBLK * KP, (unsigned)__builtin_amdgcn_readfirstlane(kdst + (slot)))
  #define DMA_V(t, slot) glds16(vsrc + (long)(t) * KVBLK * KP, (unsigned)__builtin_amdgcn_readfirstlane(vdst + (slot)))
  const int vb0 = (int)(lds0 + LDS_V) + ((lane >> 4) & 1) * 32 + (lane & 3) * 8 + (4 * hi + ((lane & 15) >> 2)) * 64;
  const char* Kbase = shm + LDS_K; bf16x8 kf[8];
  const lds_cptr shm3 = (lds_cptr)shm; const lds_cptr kp0 = shm3 + LDS_K + hi * 1024 + r32 * 16; const lds_cptr vp0 = shm3 + LDS_V + ((lane >> 4) & 1) * 32 + (lane & 3) * 8 + (4 * hi + ((lane & 15) >> 2)) * 64;
  constexpr int NT = SKV / KVBLK;
  DMA_K(0, 0); DMA_V(0, 0); DMA_K(1, SLOTB);
  bf16x8 qr[4];
  #pragma unroll
  for (int d0 = 0; d0 < 4; ++d0) qr[d0] = *reinterpret_cast<const bf16x8*>(&Qw[(long)r32 * QP + d0 * 16 + hi * 8]);
  float mhat = 0.f, l_reg = 0.f; f32x16 o[2]; o[0] = f32x16{}; o[1] = f32x16{}; f32x16 negm = f32x16{}; asm volatile("" : "+v"(negm));
  bool resc = false;
  #define START(P0, P1) do { const float rm = rowmax(P0, P1); resc = false; \
    { const float dl = rm; mhat = fadd_s(mhat, dl); \
      _Pragma("unroll") for (int r = 0; r < 16; ++r) { P0[r] = fsub_s(P0[r], dl); P1[r] = fsub_s(P1[r], dl); } \
      _Pragma("unroll") for (int r = 0; r < 16; ++r) negm[r] = -mhat; asm volatile("" : "+v"(negm)); } \
    _Pragma("unroll") for (int r = 0; r < 16; ++r) P0[r] = __builtin_amdgcn_exp2f(P0[r]); } while (0)
  #define RESC() do { if (resc) { asm volatile("s_waitcnt lgkmcnt(0)" ::: "memory"); \
      _Pragma("unroll") for (int d_ = 0; d_ < 2; ++d_) _Pragma("unroll") for (int r = 0; r < 16; ++r) o[d_][r] *= wsf[crow(r, hi)]; } } while (0)
  f32x16 pA0, pA1, pB0, pB1;
  int sl_prev = 0, sl_cur = 0, sl_next = SLOTB;
  #define ROT() do { sl_prev = sl_cur; sl_cur = sl_next; sl_next = (sl_next == (NSLOT - 1) * SLOTB) ? 0 : sl_next + SLOTB; } while (0)
  DMA_K(2, 2 * SLOTB);
  WAIT_BAR(3);
  qkt(pA0, pA1, Kbase, qr, negm, r32, hi); asm volatile("s_nop 15\n\ts_nop 7" : "+v"(pA0), "+v"(pA1));
  START(pA0, pA1);
  _Pragma("unroll") for (int r = 0; r < 16; ++r) pA1[r] = __builtin_amdgcn_exp2f(pA1[r]);
  WAIT_BAR(0);
  DMA_K(3, 0); DMA_V(1, SLOTB);
  ROT();
  kload8(kf, kp0 + sl_cur);
  WAIT_BAR(2);
  s16x4 vlo[8], vhi[8]; u32x4 pw0, pw1, pw2, pw3;
  #define PKW(P, B) cvtpk_s(P[B], P[B + 1])
  #define PAF(k) __builtin_bit_cast(bf16x8, pw##k)
  #define VFR(i) (bf16x8){vlo[i][0], vlo[i][1], vlo[i][2], vlo[i][3], vhi[i][0], vhi[i][1], vhi[i][2], vhi[i][3]}
  #define PIN(x) asm volatile("" : "+v"(x))
  #define MX3(a, b, c) __builtin_fmaxf(__builtin_fmaxf((a), (b)), (c))
  #define GAPA(MF, A0, A1, A2, A3, W0, W1, PW) do { MF; sacc += A0; sacc += A1; sacc += A2; sacc += A3; PIN(sacc); W0; W1; PIN(PW); SBAR(); } while (0)
  #define EX(v) __builtin_amdgcn_exp2f(v)
  #define GAPB(MF, X, B) do { MF; X[B] = EX(X[B]); X[B + 1] = EX(X[B + 1]); X[B + 2] = EX(X[B + 2]); X[B + 3] = EX(X[B + 3]); PIN(X); SBAR(); } while (0)
  #define VRD(i) do { vlo[i] = vtr(vp_ + (((i) >> 2) * 4096 + ((i) & 3) * 1024)); vhi[i] = vtr(vp_ + (((i) >> 2) * 4096 + ((i) & 3) * 1024 + 512)); } while (0)
  #define KRD(G, j) do { if (G) { kload2(kf, kp0 + sl_next, j); SBAR(); } } while (0)
  #define STEP(C0, C1, P0, P1, t, GK, GV, GL) do { SBAR(); \
    const lds_cptr vp_ = vp0 + sl_prev; \
    VRD(0); SBAR(); float sacc = (P0[0] + P0[1]); \
    GAPA(C0 = __builtin_amdgcn_mfma_f32_32x32x16_bf16(kf[0], qr[0], negm, 0, 0, 0), P0[2], P0[3], P0[4], P0[5],     pw0[0] = PKW(P0, 0), pw0[1] = PKW(P0, 2), pw0); \
    VRD(4); SBAR(); GAPA(C1 = __builtin_amdgcn_mfma_f32_32x32x16_bf16(kf[1], qr[0], negm, 0, 0, 0), P0[6], P0[7], P0[8], P0[9],     pw0[2] = PKW(P0, 4), pw0[3] = PKW(P0, 6), pw0); \
    VRD(1); SBAR(); GAPA(C0 = __builtin_amdgcn_mfma_f32_32x32x16_bf16(kf[2], qr[1], C0, 0, 0, 0),   P0[10], P0[11], P0[12], P0[13], pw1[0] = PKW(P0, 8), pw1[1] = PKW(P0, 10), pw1); \
    VRD(5); SBAR(); GAPA(C1 = __builtin_amdgcn_mfma_f32_32x32x16_bf16(kf[3], qr[1], C1, 0, 0, 0),   P0[14], P0[15], P1[0], P1[1],   pw1[2] = PKW(P0, 12), pw1[3] = PKW(P0, 14), pw1); \
    VRD(2); SBAR(); GAPA(C0 = __builtin_amdgcn_mfma_f32_32x32x16_bf16(kf[4], qr[2], C0, 0, 0, 0),   P1[2], P1[3], P1[4], P1[5],     pw2[0] = PKW(P1, 0), pw2[1] = PKW(P1, 2), pw2); \
    VRD(6); SBAR(); GAPA(C1 = __builtin_amdgcn_mfma_f32_32x32x16_bf16(kf[5], qr[2], C1, 0, 0, 0),   P1[6], P1[7], P1[8], P1[9],     pw2[2] = PKW(P1, 4), pw2[3] = PKW(P1, 6), pw2); \
    VRD(3); SBAR(); GAPA(C0 = __builtin_amdgcn_mfma_f32_32x32x16_bf16(kf[6], qr[3], C0, 0, 0, 0),   P1[10], P1[11], P1[12], P1[13], pw3[0] = PKW(P1, 8), pw3[1] = PKW(P1, 10), pw3); \
    VRD(7); SBAR(); GAPA(C1 = __builtin_amdgcn_mfma_f32_32x32x16_bf16(kf[7], qr[3], C1, 0, 0, 0),   P1[14], P1[15], 0.f, 0.f,       pw3[2] = PKW(P1, 12), pw3[3] = PKW(P1, 14), pw3); \
    l_reg += sacc; \
    if (GK) { DMA_K((t) + 3, sl_cur); } if (GV) { DMA_V((t) + 1, sl_next); } \
    { float a = MX3(C0[0], C0[1], C1[0]), b_ = MX3(C0[2], C0[3], C1[1]); a = MX3(a, C1[2], C1[3]); \
      _Pragma("unroll") for (int r = 4; r < 16; r += 4) { a = MX3(a, C0[r], C0[r + 1]); b_ = MX3(b_, C0[r + 2], C0[r + 3]); a = MX3(a, C1[r], C1[r + 1]); b_ = MX3(b_, C1[r + 2], C1[r + 3]); } \
      float rm = __builtin_fmaxf(a, b_); { auto rr = __builtin_amdgcn_permlane32_swap(__float_as_uint(rm), __float_as_uint(rm), false, false); rm = __builtin_fmaxf(__uint_as_float(rr[0]), __uint_as_float(rr[1])); } \
      resc = false; \
      if (__builtin_expect(__any(rm > (float)THRL), 0)) { const float dl = __builtin_fmaxf(rm, 0.f); mhat += dl; \
        _Pragma("unroll") for (int r = 0; r < 16; ++r) { C0[r] -= dl; C1[r] -= dl; } \
        _Pragma("unroll") for (int r = 0; r < 16; ++r) negm[r] = -mhat; asm volatile("" : "+v"(negm)); \
        const float f = __builtin_amdgcn_exp2f(-dl); l_reg *= f; if (hi == 0) wsf[r32] = f; resc = true; } } \
    SBAR(); \
    GAPB(o[0] = __builtin_amdgcn_mfma_f32_32x32x16_bf16(PAF(0), VFR(0), o[0], 0, 0, 0), C0, 0); \
    GAPB(o[1] = __builtin_amdgcn_mfma_f32_32x32x16_bf16(PAF(0), VFR(4), o[1], 0, 0, 0), C0, 4); \
    KRD(GL, 0); GAPB(o[0] = __builtin_amdgcn_mfma_f32_32x32x16_bf16(PAF(1), VFR(1), o[0], 0, 0, 0), C0, 8); \
    KRD(GL, 1); GAPB(o[1] = __builtin_amdgcn_mfma_f32_32x32x16_bf16(PAF(1), VFR(5), o[1], 0, 0, 0), C0, 12); \
    KRD(GL, 2); GAPB(o[0] = __builtin_amdgcn_mfma_f32_32x32x16_bf16(PAF(2), VFR(2), o[0], 0, 0, 0), C1, 0); \
    KRD(GL, 3); GAPB(o[1] = __builtin_amdgcn_mfma_f32_32x32x16_bf16(PAF(2), VFR(6), o[1], 0, 0, 0), C1, 4); \
    GAPB(o[0] = __builtin_amdgcn_mfma_f32_32x32x16_bf16(PAF(3), VFR(3), o[0], 0, 0, 0), C1, 8); \
    GAPB(o[1] = __builtin_amdgcn_mfma_f32_32x32x16_bf16(PAF(3), VFR(7), o[1], 0, 0, 0), C1, 12); \
    } while (0)
  int t = 1;
  for (; t + 5 < NT; t += 2) {
    STEP(pB0, pB1, pA0, pA1, t, true, true, true);     WAIT_BAR(2); RESC(); ROT();
    STEP(pA0, pA1, pB0, pB1, t + 1, true, true, true); WAIT_BAR(2); RESC(); ROT();
  }
  #define ENDW(tt) do { if ((tt) + 3 < NT) { WAIT_BAR(2); } else if ((tt) + 2 < NT) { WAIT_BAR(1); } else { WAIT_BAR(0); } } while (0)
  for (; t + 1 < NT; t += 2) {
    STEP(pB0, pB1, pA0, pA1, t, (t + 3 < NT), (t + 1 < NT), (t + 1 < NT));         ENDW(t);     RESC(); ROT();
    STEP(pA0, pA1, pB0, pB1, t + 1, (t + 4 < NT), (t + 2 < NT), (t + 2 < NT));     ENDW(t + 1); RESC(); ROT();
  }
  STEP(pB0, pB1, pA0, pA1, NT - 1, false, false, false); RESC();
  { float sacc = pB0[0] + pB0[1]; _Pragma("unroll") for (int r = 2; r < 16; ++r) sacc += pB0[r]; _Pragma("unroll") for (int r = 0; r < 16; ++r) sacc += pB1[r]; l_reg += sacc;
    pw0 = (u32x4){PKW(pB0, 0), PKW(pB0, 2), PKW(pB0, 4), PKW(pB0, 6)}; pw1 = (u32x4){PKW(pB0, 8), PKW(pB0, 10), PKW(pB0, 12), PKW(pB0, 14)}; pw2 = (u32x4){PKW(pB1, 0), PKW(pB1, 2), PKW(pB1, 4), PKW(pB1, 6)}; pw3 = (u32x4){PKW(pB1, 8), PKW(pB1, 10), PKW(pB1, 12), PKW(pB1, 14)};
    SBAR(); pv(o, vb0 + sl_cur, PAF(0), PAF(1), PAF(2), PAF(3)); }
  #undef PKW
  #undef PAF
  #undef VFR
  #undef PIN
  #undef MX3
  #undef GAPA
  #undef GAPB
  #undef EX
  #undef VRD
  #undef KRD
  #undef STEP
  #undef ENDW
  { auto rr = __builtin_amdgcn_permlane32_swap(__float_as_uint(l_reg), __float_as_uint(l_reg), false, false); l_reg = __uint_as_float(rr[0]) + __uint_as_float(rr[1]); }
  if (hi == 0) wsf[32 + r32] = l_reg; asm volatile("s_waitcnt lgkmcnt(0)" ::: "memory");
  float rli[16];
  #pragma unroll
  for (int r = 0; r < 16; ++r) rli[r] = __builtin_amdgcn_rcpf(wsf[32 + crow(r, hi)]);
  bf16* Ow = O + ((long)b * SEQ + q0 + wid * QBLK) * OP + h * D;
  { bf16* stg = (bf16*)(shm + LDS_OST) + wid * 2048;
    #pragma unroll
    for (int r = 0; r < 16; ++r) { const int orow = crow(r, hi);
      #pragma unroll
      for (int d0 = 0; d0 < 2; ++d0) stg[orow * 64 + d0 * 32 + r32] = __float2bfloat16(o[d0][r] * rli[r]); }
    asm volatile("s_waitcnt lgkmcnt(0)" ::: "memory");
    const int ch = lane & 7;
    const f32x4 g0 = *(const f32x4*)(og + h * D + ch * 8), g1 = *(const f32x4*)(og + h * D + ch * 8 + 4);
    #pragma unroll
    for (int i = 0; i < 4; ++i) { const int row = i * 8 + (lane >> 3); const u32x4 v = *(const u32x4*)(stg + row * 64 + ch * 8);
      float f[8]; f[0] = bf_lo(v.x); f[1] = bf_hi(v.x); f[2] = bf_lo(v.y); f[3] = bf_hi(v.y); f[4] = bf_lo(v.z); f[5] = bf_hi(v.z); f[6] = bf_lo(v.w); f[7] = bf_hi(v.w);
      float ss = 0.f;
      #pragma unroll
      for (int j = 0; j < 8; ++j) ss += f[j] * f[j];
      ss += __shfl_xor(ss, 1); ss += __shfl_xor(ss, 2); ss += __shfl_xor(ss, 4);
      const float rstd = 1.0f / sqrtf(ss * (1.0f / 64.0f) + EPS);
      u32x4 w; w.x = cvtpk_s(f[0] * rstd * g0[0], f[1] * rstd * g0[1]); w.y = cvtpk_s(f[2] * rstd * g0[2], f[3] * rstd * g0[3]); w.z = cvtpk_s(f[4] * rstd * g1[0], f[5] * rstd * g1[1]); w.w = cvtpk_s(f[6] * rstd * g1[2], f[7] * rstd * g1[3]);
      *(u32x4*)(Ow + (long)row * OP + ch * 8) = w; } }
  asm volatile("s_waitcnt lgkmcnt(0)\n\ts_barrier" ::: "memory");
  #undef DMA_K
  #undef DMA_V
  #undef START
  #undef RESC
  #undef ROT
}
#undef SBAR
#undef WAIT_BAR
}

#define XB_TMO      128
#define XB_XCNT(j)  (256  + 64 * (j))
#define XB_XSUB(j)  (1280 + 64 * (j))
#define XB_XGEN(j)  (2304 + 64 * (j))
#define XB_TOP      3328
#define XB_TOPGEN   3392
#define XCD_BAR_WORDS 3456
#define XB_SPIN_CAP (1u << 18)
__device__ __forceinline__ unsigned xb_ld(unsigned* p)              { return __hip_atomic_load(p, __ATOMIC_RELAXED, __HIP_MEMORY_SCOPE_AGENT); }
__device__ __forceinline__ unsigned xb_add(unsigned* p, unsigned v) { return __hip_atomic_fetch_add(p, v, __ATOMIC_RELAXED, __HIP_MEMORY_SCOPE_AGENT); }
__device__ __forceinline__ unsigned xb_xcc_id() { return (unsigned)__builtin_amdgcn_s_getreg((3 << 11) | 20) & 0xFu; }
#define XB_SPIN(cond, bar) do { unsigned _sp = 0; while (cond) { __builtin_amdgcn_s_sleep(1); \
    if ((++_sp & 255u) == 0u) { if (xb_ld(&(bar)[XB_TMO])) break; if (_sp > XB_SPIN_CAP) { atomicAdd(&(bar)[XB_TMO], 1u); break; } } } } while (0)
struct XcdBarrier { unsigned* bar; unsigned x; volatile LAS unsigned* st; };
__device__ __forceinline__ XcdBarrier xcd_barrier_post(unsigned* bar, volatile LAS unsigned* st) {
    XcdBarrier b; b.bar = bar; b.x = xb_xcc_id(); b.st = st;
    if (threadIdx.x == 0) (void)xb_add(&bar[XB_XCNT(b.x)], 1u);
    return b;
}
__device__ __forceinline__ void xcd_barrier_complete(unsigned* bar, unsigned x, unsigned& nloc, unsigned& nx) {
    const unsigned G = gridDim.x * gridDim.y * gridDim.z;
    unsigned sum, cnt, mine, sp = 0u;
    for (;;) {
        sum = 0u; cnt = 0u; mine = 0u;
#pragma unroll
        for (unsigned j = 0; j < 16; ++j) { const unsigned c = xb_ld(&bar[XB_XCNT(j)]); sum += c; cnt += (c > 0u) ? 1u : 0u; mine = (j == x) ? c : mine; }
        if (sum == G) break;
        __builtin_amdgcn_s_sleep(1);
        if ((++sp & 255u) == 0u) { if (xb_ld(&bar[XB_TMO])) break; if (sp > XB_SPIN_CAP) { atomicAdd(&bar[XB_TMO], 1u); break; } }
    }
    nloc = mine > 0u ? mine : 1u; nx = cnt > 0u ? cnt : 1u;
}
__device__ __forceinline__ void xcd_barrier(const XcdBarrier& b) {
    asm volatile("s_waitcnt vmcnt(0)" ::: "memory");
    __syncthreads();
    if (threadIdx.x == 0) {
        unsigned* bar = b.bar;
        __builtin_amdgcn_s_waitcnt(0);
        unsigned nloc = b.st[0], nx = b.st[1];
        if (nloc == 0u) { xcd_barrier_complete(bar, b.x, nloc, nx); b.st[0] = nloc; b.st[1] = nx; }
        const unsigned old = xb_add(&bar[XB_XSUB(b.x)], 1u);
        const unsigned gen = old / nloc;
        if (old + 1u == (gen + 1u) * nloc) {
            __builtin_amdgcn_fence(__ATOMIC_RELEASE, "agent");
            asm volatile("s_waitcnt vmcnt(0)" ::: "memory");
            const unsigned og = xb_add(&bar[XB_TOP], 1u);
            const unsigned tg = og / nx;
            if (og + 1u == (tg + 1u) * nx) xb_add(&bar[XB_TOPGEN], 1u);
            else XB_SPIN(xb_ld(&bar[XB_TOPGEN]) == tg, bar);
            __builtin_amdgcn_fence(__ATOMIC_ACQUIRE, "agent");
            xb_add(&bar[XB_XGEN(b.x)], 1u);
            asm volatile("s_waitcnt vmcnt(0)" ::: "memory");
        } else {
            XB_SPIN(xb_ld(&bar[XB_XGEN(b.x)]) == gen, bar);
            __builtin_amdgcn_fence(__ATOMIC_ACQUIRE, "agent");
            asm volatile("s_waitcnt vmcnt(0)" ::: "memory");
        }
    }
    __syncthreads();
}

struct Args {
    const float *x, *c, *ctx, *c_ctx, *w_mod, *b_mod, *norm1_g, *w_in, *q_g, *k_g, *conv_w, *attn_g, *conv_g, *w_out, *norm2_g, *w_group, *w_router, *w_gate, *w_up, *w_down, *final_g;
    float* out; unsigned char* ws; int ph_lo, ph_hi;
};

template <class RowMap>
__device__ __forceinline__ void transpose_item(const float* __restrict__ W, int K, int N, bf16_t* WT, LAS float* scr, int k0, int n0, int lane, RowMap rm) {
    f32x4 v[16];
#pragma unroll
    for (int i = 0; i < 16; ++i) { const int kk = 4 * i + (lane >> 4); v[i] = *(const f32x4*)(W + (size_t)(k0 + kk) * N + n0 + 4 * (lane & 15)); }
#pragma unroll
    for (int i = 0; i < 16; ++i) { const int kk = 4 * i + (lane >> 4); LAS float* p = scr + kk * 65 + 4 * (lane & 15); p[0] = v[i][0]; p[1] = v[i][1]; p[2] = v[i][2]; p[3] = v[i][3]; }
    asm volatile("s_waitcnt lgkmcnt(0)" ::: "memory");
    const int c = lane & 7;
#pragma unroll
    for (int j = 0; j < 8; ++j) { const int n = 8 * j + (lane >> 3); const LAS float* s = scr + (8 * c) * 65 + n;
        u32x4 o; o.x = cvt_pk_bf16(s[0 * 65], s[1 * 65]); o.y = cvt_pk_bf16(s[2 * 65], s[3 * 65]); o.z = cvt_pk_bf16(s[4 * 65], s[5 * 65]); o.w = cvt_pk_bf16(s[6 * 65], s[7 * 65]);
        *(u32x4*)(WT + (size_t)rm(n0 + n) * K + k0 + 8 * c) = o; }
    asm volatile("s_waitcnt lgkmcnt(0)" ::: "memory");
}
struct MapWin { __device__ __forceinline__ int operator()(int n) const { return drow_win(n); } };
struct MapId  { __device__ __forceinline__ int operator()(int n) const { return n; } };
struct MapGU  { int up; __device__ __forceinline__ int operator()(int n) const { return drow_gu(n, up); } };
struct MapDn  { __device__ __forceinline__ int operator()(int n) const { return drow_dn(n); } };

__device__ __forceinline__ void sincos_small(double a, double& s, double& c) {
    const double n = rint(a * 0.63661977236758134308);
    double r = fma(-n, 1.57079632679489655800, a); r = fma(-n, 6.12323399573676603587e-17, r);
    const double r2 = r * r;
    double sp = -7.6471637318198164759e-13;
    sp = fma(sp, r2, 1.6059043836821614599e-10);
    sp = fma(sp, r2, -2.5052108385441718775e-08);
    sp = fma(sp, r2, 2.7557319223985890653e-06);
    sp = fma(sp, r2, -1.9841269841269841270e-04);
    sp = fma(sp, r2, 8.3333333333333333333e-03);
    sp = fma(sp, r2, -1.6666666666666666667e-01);
    sp = fma(sp * r2, r, r);
    double cp = 4.7794773323873852974e-14;
    cp = fma(cp, r2, -1.1470745597729724714e-11);
    cp = fma(cp, r2, 2.0876756987868098979e-09);
    cp = fma(cp, r2, -2.7557319223985890653e-07);
    cp = fma(cp, r2, 2.4801587301587301587e-05);
    cp = fma(cp, r2, -1.3888888888888888889e-03);
    cp = fma(cp, r2, 4.1666666666666666667e-02);
    cp = fma(cp, r2, -0.5);
    cp = fma(cp, r2, 1.0);
    const int q = ((int)n) & 3;
    s = (q == 0) ? sp : (q == 1) ? cp : (q == 2) ? -sp : -cp;
    c = (q == 0) ? cp : (q == 1) ? -sp : (q == 2) ? -cp : sp;
}

__global__ void __launch_bounds__(512, 2) mk_fwd(Args A) {
    extern __shared__ __attribute__((aligned(16))) unsigned char lds_raw[];
    LAS unsigned char* lds = (LAS unsigned char*)lds_raw;
    const int G = gridDim.x, bx = blockIdx.x;
    const int vcu = (G % 8 == 0) ? (bx % 8) * (G / 8) + bx / 8 : bx;
    gu32* ctl = (gu32*)(A.ws + WS_CTL);
    const int NGW = G * 8;
#define PHASE_IDS() int tid = threadIdx.x; asm volatile("" : "+v"(tid)); const int lane = tid & 63, wave = __builtin_amdgcn_readfirstlane(tid >> 6); const int gw = vcu * 8 + wave; (void)gw; (void)lane
#define WSP(T, off) ((T*)(A.ws + (off)))
    { PHASE_IDS(); for (int u = tid; u < (LDS_BYTES - MISC_OFF) / 4; u += 512) ((LAS unsigned*)(lds + MISC_OFF))[u] = 0u; }
    __syncthreads();
    XcdBarrier bar; bar.bar = (unsigned*)(ctl + CW_BAR); bar.x = 0; bar.st = nullptr;
    if (MK_N_LAUNCHES == 1) bar = xcd_barrier_post((unsigned*)(ctl + CW_BAR), (volatile LAS unsigned*)(lds + MISC_OFF) + 8);
    const int lo = A.ph_lo, hi = A.ph_hi;
#define IN(k) (lo <= (k) && (k) < hi)
#define SEAM(k) do { if (IN(k) && IN((k) + 1)) xcd_barrier(bar); } while (0)

    if (IN(0)) REP(0) {
        PHASE_IDS();
        float* MOD = WSP(float, WS_MOD); float* COS_T = WSP(float, WS_ROPE); float* SIN_T = COS_T + 1024;
        bf16_t* WIN_T = WSP(bf16_t, WS_WIN); bf16_t* WOUT_T = WSP(bf16_t, WS_WOUT); bf16_t* WUP_T = WSP(bf16_t, WS_WUP); bf16_t* WDN_T = WSP(bf16_t, WS_WDN);
        if (bx < 192) {
            LAS float* sc = (LAS float*)lds;
            for (int i = tid; i < 9 * 1024; i += 512) { const int b = i >> 10, k = i & 1023; const float v = (b < 8) ? A.c[b * 1024 + k] : A.c_ctx[k]; sc[i] = v / (1.0f + expf(-v)); }
            __syncthreads();
            const int col = 32 * bx + (lane & 31), kh = lane >> 5;
            float a0 = 0.f, a1 = 0.f, a2 = 0.f, a3 = 0.f, a4 = 0.f, a5 = 0.f, a6 = 0.f, a7 = 0.f, a8 = 0.f;
#pragma unroll 8
            for (int it = 0; it < 64; ++it) { const int k = 128 * wave + 2 * it + kh; const float w = A.w_mod[(size_t)k * 6144 + col];
                a0 += sc[k] * w; a1 += sc[1024 + k] * w; a2 += sc[2048 + k] * w; a3 += sc[3072 + k] * w; a4 += sc[4096 + k] * w; a5 += sc[5120 + k] * w; a6 += sc[6144 + k] * w; a7 += sc[7168 + k] * w; a8 += sc[8192 + k] * w; }
            a0 += __shfl_xor(a0, 32); a1 += __shfl_xor(a1, 32); a2 += __shfl_xor(a2, 32); a3 += __shfl_xor(a3, 32); a4 += __shfl_xor(a4, 32); a5 += __shfl_xor(a5, 32); a6 += __shfl_xor(a6, 32); a7 += __shfl_xor(a7, 32); a8 += __shfl_xor(a8, 32);
            LAS float* part = sc + 9 * 1024;
            if (lane < 32) { LAS float* p = part + wave * 288 + lane; p[0] = a0; p[32] = a1; p[64] = a2; p[96] = a3; p[128] = a4; p[160] = a5; p[192] = a6; p[224] = a7; p[256] = a8; }
            __syncthreads();
            if (tid < 288) { const int b = tid >> 5, cc = tid & 31; float s = 0.f;
#pragma unroll
                for (int w = 0; w < 8; ++w) s += part[w * 288 + b * 32 + cc];
                MOD[b * 6144 + 32 * bx + cc] = s + A.b_mod[32 * bx + cc]; }
            __syncthreads();
        }
        if (bx == G - 1) {
            for (int i = tid; i < 1024; i += 512) { const int idx = i >> 4, f = i & 15; double inv = 1.0; for (int j = 0; j < f; ++j) inv *= 0.56234132519034908039;
                double s, c; sincos_small((double)idx * inv, s, c); COS_T[i] = (float)c; SIN_T[i] = (float)s; }
        }
        if (bx == G - 2) {
            float* WRT = WSP(float, WS_WRT);
            for (int k = tid; k < DM; k += 512) {
                const f32x4 wg = *(const f32x4*)(A.w_group + (size_t)k * 4);
                WRT[0 * DM + k] = wg[0]; WRT[1 * DM + k] = wg[1]; WRT[2 * DM + k] = wg[2]; WRT[3 * DM + k] = wg[3];
#pragma unroll
                for (int q = 0; q < 8; ++q) { const f32x4 w = *(const f32x4*)(A.w_router + (size_t)k * 32 + 4 * q);
                    WRT[(4 + 4 * q + 0) * DM + k] = w[0]; WRT[(4 + 4 * q + 1) * DM + k] = w[1]; WRT[(4 + 4 * q + 2) * DM + k] = w[2]; WRT[(4 + 4 * q + 3) * DM + k] = w[3]; }
            }
        }
        {
            LAS float* scr = (LAS float*)(lds + wave * 16640);
            constexpr int I_IN = 16 * 36, I_OUT = 16 * 16, I_G = 16 * 12, I_D = 12 * 16, I_E = 2 * I_G + I_D;
            constexpr int NITEMS = I_IN + I_OUT + NE * I_E;
            for (int it = gw; it < NITEMS; it += NGW) {
                int r = it;
                if (r < I_IN) { transpose_item(A.w_in, DM, NCOLS, WIN_T, scr, 64 * (r / 36), 64 * (r % 36), lane, MapWin{}); continue; } r -= I_IN;
                if (r < I_OUT) { transpose_item(A.w_out, DM, DM, WOUT_T, scr, 64 * (r / 16), 64 * (r % 16), lane, MapId{}); continue; } r -= I_OUT;
                const int e = r / I_E; r -= e * I_E;
                if (r < I_G) { transpose_item(A.w_gate + (size_t)e * DM * DE, DM, DE, WUP_T + (size_t)e * NUP * DM, scr, 64 * (r / 12), 64 * (r % 12), lane, MapGU{0}); continue; } r -= I_G;
                if (r < I_G) { transpose_item(A.w_up + (size_t)e * DM * DE, DM, DE, WUP_T + (size_t)e * NUP * DM, scr, 64 * (r / 12), 64 * (r % 12), lane, MapGU{1}); continue; } r -= I_G;
                transpose_item(A.w_down + (size_t)e * DE * DM, DE, DM, WDN_T + (size_t)e * DM * DE, scr, 64 * (r / 16), 64 * (r % 16), lane, MapDn{});
            }
        }
        if (PROBE_REPEAT == 0) __syncthreads();
    }
    SEAM(0);

    if (IN(1)) REP(1) {
        PHASE_IDS();
        const float* MOD = WSP(float, WS_MOD); bf16_t* HX = WSP(bf16_t, WS_HX);
        for (int m = gw; m < MROWS; m += NGW) {
            const bool lat = m < NTOK; const int b = lat ? (m >> 11) : 8;
            const float* xrow = lat ? (A.x + (size_t)m * DM) : (A.ctx + (size_t)(m - NTOK) * DM);
            const float* md = MOD + b * 6144;
            f32x4 v[4]; float s = 0.f;
#pragma unroll
            for (int j = 0; j < 4; ++j) { v[j] = *((const f32x4*)xrow + lane + 64 * j); s += (v[j][0] * v[j][0] + v[j][1] * v[j][1]) + (v[j][2] * v[j][2] + v[j][3] * v[j][3]); }
            const float rstd = 1.0f / sqrtf(wave_sum(s) * (1.0f / DM) + EPS);
#pragma unroll
            for (int j = 0; j < 4; ++j) { const int col = 4 * lane + 256 * j;
                const f32x4 g = *(const f32x4*)(A.norm1_g + col), sh = *(const f32x4*)(md + col), sc = *(const f32x4*)(md + 1024 + col);
                const f32x4 y = v[j] * rstd * g * (sc + 1.0f) + sh;
                u32x2 w; w.x = cvt_pk_bf16(y[0], y[1]); w.y = cvt_pk_bf16(y[2], y[3]); *(u32x2*)(HX + (size_t)m * DM + col) = w; }
        }
    }
    SEAM(1);

#define P2_BODY { pg8::GridOrder S{64, 9, G, bx, 8, 2, DM, (const char*)(A.ws + WS_WIN)}; \
        pg8::EpiIn E{WSP(bf16_t, WS_Q), WSP(bf16_t, WS_KB), WSP(bf16_t, WS_VB), WSP(bf16_t, WS_GB), WSP(bf16_t, WS_WB), A.q_g, A.k_g, WSP(float, WS_ROPE), WSP(float, WS_ROPE) + 1024}; \
        pg8::gemm_phase<pg8::EpiIn, pg8::GridOrder, true>(lds, (const char*)(A.ws + WS_HX), DM, S, E); }
    if (IN(2)) { P2_BODY if (PROBE_REPEAT == 2) P2_BODY }
    SEAM(2);

    if (IN(3)) REP(3) {
        PHASE_IDS();
        const bf16_t* WBUF = WSP(bf16_t, WS_WB); const bf16_t* GBUF = WSP(bf16_t, WS_GB); bf16_t* MIX = WSP(bf16_t, WS_MIX);
        {
            const int c0 = 8 * lane;
            f32x4 t0a = *(const f32x4*)(A.conv_w + c0), t0b = *(const f32x4*)(A.conv_w + c0 + 4), t1a = *(const f32x4*)(A.conv_w + 512 + c0), t1b = *(const f32x4*)(A.conv_w + 512 + c0 + 4),
                  t2a = *(const f32x4*)(A.conv_w + 1024 + c0), t2b = *(const f32x4*)(A.conv_w + 1024 + c0 + 4);
            const f32x4 cga = *(const f32x4*)(A.conv_g + c0), cgb = *(const f32x4*)(A.conv_g + c0 + 4);
            for (int m = gw; m < NTOK; m += NGW) {
                const int t = m & (SEQ - 1);
                const u32x4 z = (u32x4){0u, 0u, 0u, 0u};
                const u32x4 vm = (t > 0) ? *(const u32x4*)(WBUF + (size_t)(m - 1) * CW + c0) : z;
                const u32x4 v0 = *(const u32x4*)(WBUF + (size_t)m * CW + c0);
                const u32x4 vp = (t < SEQ - 1) ? *(const u32x4*)(WBUF + (size_t)(m + 1) * CW + c0) : z;
                const u32x4 gb = *(const u32x4*)(GBUF + (size_t)m * CW + c0);
                float y[8];
#define CONV2(k, W_, TA, TB, TC, q) y[2 * (k)] = bf_lo(gb.W_) * (TA[q] * bf_lo(vm.W_) + TB[q] * bf_lo(v0.W_) + TC[q] * bf_lo(vp.W_)); \
                                    y[2 * (k) + 1] = bf_hi(gb.W_) * (TA[q + 1] * bf_hi(vm.W_) + TB[q + 1] * bf_hi(v0.W_) + TC[q + 1] * bf_hi(vp.W_));
                CONV2(0, x, t0a, t1a, t2a, 0) CONV2(1, y, t0a, t1a, t2a, 2) CONV2(2, z, t0b, t1b, t2b, 0) CONV2(3, w, t0b, t1b, t2b, 2)
#undef CONV2
                float ss = 0.f;
#pragma unroll
                for (int j = 0; j < 8; ++j) ss += y[j] * y[j];
                ss += __shfl_xor(ss, 1); ss += __shfl_xor(ss, 2); ss += __shfl_xor(ss, 4);
                const float rstd = 1.0f / sqrtf(ss * (1.0f / 64.0f) + EPS);
                u32x4 w; w.x = cvt_pk_bf16(y[0] * rstd * cga[0], y[1] * rstd * cga[1]); w.y = cvt_pk_bf16(y[2] * rstd * cga[2], y[3] * rstd * cga[3]);
                w.z = cvt_pk_bf16(y[4] * rstd * cgb[0], y[5] * rstd * cgb[1]); w.w = cvt_pk_bf16(y[6] * rstd * cgb[2], y[7] * rstd * cgb[3]);
                *(u32x4*)(MIX + (size_t)m * DM + 512 + c0) = w;
            }
        }
        asm volatile("s_waitcnt vmcnt(0)" ::: "memory"); __syncthreads();
        for (int uu = vcu; uu < 256; uu += G) {
            const int p = uu >> 4, w16 = uu & 15, b = p >> 1, kvh = p & 1;
#pragma unroll 1
            for (int j = 0; j < 2; ++j) { const int un = 2 * w16 + j, hq = un >> 3, qb = un & 7;
                attn_body::attn_unit<8>(b, kvh * 4 + hq, qb, WSP(const attn_body::bf16, WS_Q), WSP(const attn_body::bf16, WS_KB), WSP(const attn_body::bf16, WS_VB), WSP(attn_body::bf16, WS_MIX), A.attn_g, (char*)lds_raw); }
        }
    }
    SEAM(3);

#define P4_BODY { pg8::GridOrder S{64, 4, G, bx, 0, 0, DM, (const char*)(A.ws + WS_WOUT)}; \
        pg8::EpiOut E{A.x, WSP(const float, WS_MOD), A.out}; \
        pg8::gemm_phase<pg8::EpiOut, pg8::GridOrder, true>(lds, (const char*)(A.ws + WS_MIX), DM, S, E); }
    if (IN(4)) { P4_BODY if (PROBE_REPEAT == 4) P4_BODY }
    SEAM(4);

    if (IN(5)) REP(5) {
        PHASE_IDS();
        if (PROBE_REPEAT == 5 && rep_ == 1) { xcd_barrier(bar); if (bx == 0 && tid < 32) __hip_atomic_store((unsigned*)(ctl + CW_CNT) + tid, 0u, RLX_AGENT); xcd_barrier(bar); }
        const float* MOD = WSP(float, WS_MOD); const float* XNEW = A.out; bf16_t* HX2 = WSP(bf16_t, WS_HX2); int* TOKI = WSP(int, WS_TOKI); float* TOKW = WSP(float, WS_TOKW); int* LIST = WSP(int, WS_LIST);
        unsigned* CNT = (unsigned*)(ctl + CW_CNT);
        LAS int* lcnt = (LAS int*)(lds + P5S_OFF); LAS int* lbase = lcnt + 32; LAS int* sel = lbase + 32; LAS int* rnk = sel + 128;
        { const f32x4* src4 = (const f32x4*)WSP(float, WS_WRT); LAS f32x4* dst4 = (LAS f32x4*)lds;
          for (int i = tid; i < WRT_BYTES / 16; i += 512) dst4[i] = src4[i]; }
        const LAS float* WL = (const LAS float*)lds + 4 * lane;
        for (int rb = bx; rb < NTOK / 64; rb += G) {
            if (tid < 32) lcnt[tid] = 0;
            __syncthreads();
            f32x4 xa[8][4];
#pragma unroll
            for (int rr = 0; rr < 8; ++rr)
#pragma unroll
                for (int j = 0; j < 4; ++j) xa[rr][j] = *((const f32x4*)(XNEW + (size_t)(rb * 64 + wave * 8 + rr) * DM) + lane + 64 * j);
#pragma unroll
            for (int rr = 0; rr < 8; ++rr) {
                const int m = rb * 64 + wave * 8 + rr, b = m >> 11;
                const float* md = MOD + b * 6144;
                f32x4 v[4]; float s = 0.f;
#pragma unroll
                for (int j = 0; j < 4; ++j) { v[j] = xa[rr][j]; s += (v[j][0] * v[j][0] + v[j][1] * v[j][1]) + (v[j][2] * v[j][2] + v[j][3] * v[j][3]); }
                const float rstd = 1.0f / sqrtf(wave_sum_u(s) * (1.0f / DM) + EPS);
                float gl0 = 0.f, gl1 = 0.f, gl2 = 0.f, gl3 = 0.f;
#pragma unroll
                for (int j = 0; j < 4; ++j) { const int col = 4 * lane + 256 * j;
                    const f32x4 g = *(const f32x4*)(A.norm2_g + col), sh = *(const f32x4*)(md + 3072 + col), sc = *(const f32x4*)(md + 4096 + col);
                    const f32x4 y = v[j] * rstd * g * (sc + 1.0f) + sh; v[j] = y;
                    u32x2 w; w.x = cvt_pk_bf16(y[0], y[1]); w.y = cvt_pk_bf16(y[2], y[3]); *(u32x2*)(HX2 + (size_t)m * DM + col) = w;
                    { const f32x4 w0 = *(const LAS f32x4*)(WL + 256 * j), w1 = *(const LAS f32x4*)(WL + DM + 256 * j), w2 = *(const LAS f32x4*)(WL + 2 * DM + 256 * j), w3 = *(const LAS f32x4*)(WL + 3 * DM + 256 * j);
                      gl0 += (y[0] * w0[0] + y[1] * w0[1]) + (y[2] * w0[2] + y[3] * w0[3]); gl1 += (y[0] * w1[0] + y[1] * w1[1]) + (y[2] * w1[2] + y[3] * w1[3]);
                      gl2 += (y[0] * w2[0] + y[1] * w2[1]) + (y[2] * w2[2] + y[3] * w2[3]); gl3 += (y[0] * w3[0] + y[1] * w3[1]) + (y[2] * w3[2] + y[3] * w3[3]); } }
                gl0 = wave_sum_u(gl0); gl1 = wave_sum_u(gl1); gl2 = wave_sum_u(gl2); gl3 = wave_sum_u(gl3);
                int gs = 0; float gm = gl0; if (gl1 > gm) { gm = gl1; gs = 1; } if (gl2 > gm) { gm = gl2; gs = 2; } if (gl3 > gm) { gm = gl3; gs = 3; }
                gs = __builtin_amdgcn_readfirstlane(gs);
                const float gw_ = 1.0f / (expf(gl0 - gm) + expf(gl1 - gm) + expf(gl2 - gm) + expf(gl3 - gm));
                float el[8];
#pragma unroll
                for (int q = 0; q < 8; ++q) el[q] = 0.f;
                { const LAS float* wr_ = WL + (4 + gs * 8) * DM;
#pragma unroll
                  for (int q = 0; q < 8; ++q)
#pragma unroll
                    for (int j = 0; j < 4; ++j) { const f32x4 w = *(const LAS f32x4*)(wr_ + q * DM + 256 * j); el[q] += (v[j][0] * w[0] + v[j][1] * w[1]) + (v[j][2] * w[2] + v[j][3] * w[3]); } }
#pragma unroll
                for (int q = 0; q < 8; ++q) el[q] = wave_sum_u(el[q]);
                int i0 = 0; float m0 = el[0];
#pragma unroll
                for (int q = 1; q < 8; ++q) if (el[q] > m0) { m0 = el[q]; i0 = q; }
                int i1 = -1; float m1 = -3.0e38f;
#pragma unroll
                for (int q = 0; q < 8; ++q) if (q != i0 && el[q] > m1) { m1 = el[q]; i1 = q; }
                const float p1 = expf(m1 - m0), inv = 1.0f / (1.0f + p1);
                if (lane == 0) { const int a = (wave * 8 + rr) * 2; sel[a] = gs * 8 + i0; sel[a + 1] = gs * 8 + i1; *(f32x2*)(TOKW + (size_t)m * 2) = (f32x2){gw_ * inv, gw_ * p1 * inv}; }
            }
            __syncthreads();
            if (tid < 128) rnk[tid] = __hip_atomic_fetch_add(&lcnt[sel[tid]], 1, __ATOMIC_RELAXED, __HIP_MEMORY_SCOPE_WORKGROUP);
            __syncthreads();
            if (tid < 32) { const int c = lcnt[tid]; lbase[tid] = c ? (int)__hip_atomic_fetch_add(CNT + tid, (unsigned)c, RLX_AGENT) : 0; }
            __syncthreads();
            if (tid < 128) { const int e = sel[tid], pos = lbase[e] + rnk[tid], m = rb * 64 + (tid >> 1);
                TOKI[m * 4 + (tid & 1) * 2] = e; TOKI[m * 4 + (tid & 1) * 2 + 1] = pos; LIST[e * LISTCAP + pos] = m; }
            __syncthreads();
        }
    }
    SEAM(5);

#define MOE_PREFIX() \
        const int cnt_l = (lane < 32) ? (int)__hip_atomic_load(CNT + lane, RLX_AGENT) : 0; \
        const int ntl = (cnt_l + 255) >> 8; \
        int incl = ntl; \
        _Pragma("unroll") for (int o = 1; o < 32; o <<= 1) { const int t_ = __shfl_up(incl, o); if (lane >= o) incl += t_; } \
        const int excl = incl - ntl; \
        const int T = __shfl(incl, 31);
#define P6_BODY { \
        PHASE_IDS(); \
        unsigned* CNT = (unsigned*)(ctl + CW_CNT); const int* LIST = (const int*)(A.ws + WS_LIST); \
        MOE_PREFIX() \
        LAS int* tab = (LAS int*)(lds + TAB_OFF); \
        pg8::MoeOrder<true, 6> S{G, vcu, T * 6, incl, DM, (const char*)(A.ws + WS_WUP), (size_t)NUP * DM * 2, tab}; \
_Pragma("unroll 1") \
        for (int i = 0; i < 4; ++i) { pg8::Unit u; if (!S.next(i, u)) break; \
            const int mt = u.pm - __shfl(excl, u.e), ce = __shfl(cnt_l, u.e); \
            if (tid < 256) { const int pos = mt * 256 + tid; tab[i * 256 + tid] = (pos < ce) ? LIST[u.e * LISTCAP + pos] : 0; } } \
        __syncthreads(); \
        pg8::EpiUp E{(bf16_t*)(A.ws + WS_HB)}; \
        pg8::gemm_phase<pg8::EpiUp, pg8::MoeOrder<true, 6>, true>(lds, (const char*)(A.ws + WS_HX2), DM, S, E); \
    }
    if (IN(6)) { P6_BODY if (PROBE_REPEAT == 6) { __syncthreads(); P6_BODY } }
    SEAM(6);
#define P7_BODY { \
        PHASE_IDS(); \
        unsigned* CNT = (unsigned*)(ctl + CW_CNT); \
        MOE_PREFIX() \
        (void)excl; \
        pg8::MoeOrder<false, 4> S{G, vcu, T * 4, incl, DE, (const char*)(A.ws + WS_WDN), (size_t)DM * DE * 2, (const LAS int*)(lds + TAB_OFF)}; \
        pg8::EpiDown E{(bf16_t*)(A.ws + WS_YB)}; \
        pg8::gemm_phase<pg8::EpiDown, pg8::MoeOrder<false, 4>, true>(lds, (const char*)(A.ws + WS_HB), DE, S, E); \
    }
    if (IN(7)) { P7_BODY if (PROBE_REPEAT == 7) P7_BODY }
    SEAM(7);

    if (IN(8)) REP(8) {
        PHASE_IDS();
        const float* MOD = WSP(float, WS_MOD); const float* XNEW = A.out; const int* TOKI = WSP(int, WS_TOKI); const float* TOKW = WSP(float, WS_TOKW); const bf16_t* YB = WSP(bf16_t, WS_YB);
        unsigned* CNT = (unsigned*)(ctl + CW_CNT);
        MOE_PREFIX()
        (void)T;
        const unsigned tmo = __hip_atomic_load(ctl + CW_BAR + XB_TMO, RLX_AGENT);
        for (int m = gw; m < NTOK; m += NGW) {
            const int b = m >> 11; const float* md = MOD + b * 6144;
            const int e0 = TOKI[m * 4], p0 = TOKI[m * 4 + 1], e1 = TOKI[m * 4 + 2], p1 = TOKI[m * 4 + 3];
            const f32x2 tw = *(const f32x2*)(TOKW + (size_t)m * 2);
            const size_t r0 = (size_t)(__shfl(excl, e0 & 31) * 256 + p0), r1 = (size_t)(__shfl(excl, e1 & 31) * 256 + p1);
            f32x4 v[4]; float s = 0.f;
#pragma unroll
            for (int j = 0; j < 4; ++j) { const int col = 4 * lane + 256 * j;
                const f32x4 xs = *(const f32x4*)(XNEW + (size_t)m * DM + col), gt = *(const f32x4*)(md + 5120 + col);
                const u32x2 ya = *(const u32x2*)(YB + r0 * DM + col), yb = *(const u32x2*)(YB + r1 * DM + col);
                f32x4 y; y[0] = tw[0] * bf_lo(ya.x) + tw[1] * bf_lo(yb.x); y[1] = tw[0] * bf_hi(ya.x) + tw[1] * bf_hi(yb.x); y[2] = tw[0] * bf_lo(ya.y) + tw[1] * bf_lo(yb.y); y[3] = tw[0] * bf_hi(ya.y) + tw[1] * bf_hi(yb.y);
                v[j] = xs + gt * y; s += (v[j][0] * v[j][0] + v[j][1] * v[j][1]) + (v[j][2] * v[j][2] + v[j][3] * v[j][3]); }
            float rstd = 1.0f / sqrtf(wave_sum(s) * (1.0f / DM) + EPS);
            if (tmo) rstd = __builtin_nanf("");
#pragma unroll
            for (int j = 0; j < 4; ++j) { const int col = 4 * lane + 256 * j; const f32x4 g = *(const f32x4*)(A.final_g + col); *(f32x4*)(((PROBE_REPEAT == 8 && rep_ == 0) ? WSP(float, WS_WUP) : A.out) + (size_t)m * DM + col) = v[j] * rstd * g; }
        }
    }
#undef IN
#undef SEAM
#undef MOE_PREFIX
#undef PHASE_IDS
#undef WSP
}

extern "C" void kernel_launch(void* const* d_in, const int* in_sizes, int n_in, void* d_out, int out_size, void* d_ws, size_t ws_size, hipStream_t stream) {
    static int grid = 0;
    if (grid == 0) {
        if (n_in != 21 || in_sizes[0] != NTOK * DM || out_size != NTOK * DM || ws_size < WS_END) { fprintf(stderr, "kernel_launch: unexpected shapes (n_in %d, in0 %d, out %d, ws %zu < %zu)\n", n_in, n_in > 0 ? in_sizes[0] : -1, out_size, ws_size, (size_t)WS_END); grid = -1; return; }
        int dev = 0, cus = 0, per_cu = 0;
        if (hipGetDevice(&dev) != hipSuccess || hipDeviceGetAttribute(&cus, hipDeviceAttributeMultiprocessorCount, dev) != hipSuccess) { grid = -1; return; }
        if (hipFuncSetAttribute((const void*)mk_fwd, hipFuncAttributeMaxDynamicSharedMemorySize, LDS_BYTES) != hipSuccess) { fprintf(stderr, "kernel_launch: hipFuncSetAttribute failed\n"); grid = -1; return; }
        if (hipOccupancyMaxActiveBlocksPerMultiprocessor(&per_cu, (const void*)mk_fwd, 512, LDS_BYTES) != hipSuccess || per_cu < 1) fprintf(stderr, "kernel_launch: occupancy query says %d\n", per_cu);
        (void)hipGetLastError();
        grid = cus;
    }
    if (grid < 0) return;
    (void)hipMemsetAsync((char*)d_ws + WS_CTL, 0, CTL_ZERO_BYTES, stream);
    Args a{};
    const float** p = (const float**)&a;
    for (int i = 0; i < 21; ++i) p[i] = (const float*)d_in[i];
    a.out = (float*)d_out; a.ws = (unsigned char*)d_ws;
    if (MK_N_LAUNCHES == 1) { a.ph_lo = 0; a.ph_hi = N_PHASES; hipLaunchKernelGGL(mk_fwd, dim3(grid), dim3(512), LDS_BYTES, stream, a); }
    else { for (int ph = 0; ph < N_PHASES; ++ph) { a.ph_lo = ph; a.ph_hi = ph + 1; hipLaunchKernelGGL(mk_fwd, dim3(grid), dim3(512), LDS_BYTES, stream, a); } }
}
```
